# Optimizing an MI355X kernel written in HIP

```python
import math
import jax, jax.numpy as jnp
from jax import lax
import numpy as np

D_MODEL = 1024
BATCH = 16
SEQ = 2048
DEPTH = 4

D_MIX = D_MODEL
DIFF_WIDTH = D_MIX // 2
DSA_WIDTH = D_MIX - DIFF_WIDTH
DIFF_HEADS = 4
DIFF_V_DIM = DIFF_WIDTH // DIFF_HEADS
DIFF_QK_DIM = DIFF_V_DIM // 2
DSA_HEADS = 4
DSA_HEAD_DIM = DSA_WIDTH // DSA_HEADS
IDX_HEADS = 8
IDX_DIM = 64
INDEX_TOPK = 256
ROPE_THETA = 500000.0
ROPE_FRACTION = 4
Q_BLOCK = 128
NORM_EPS = 1e-6
SUBLN_EPS = 1e-5
LN_EPS = 1e-6

SPLIT_SIZES = (
    DIFF_WIDTH, DIFF_WIDTH, DIFF_WIDTH, DIFF_WIDTH,
    DSA_WIDTH, DSA_WIDTH, DSA_WIDTH, DSA_WIDTH,
    IDX_HEADS * IDX_DIM, IDX_DIM, IDX_HEADS,
)
N_IN = sum(SPLIT_SIZES)
SPLIT_OFFSETS = [int(o) for o in np.cumsum(SPLIT_SIZES)[:-1]]

kernel_name = 'hybrid_diffattn_dsa_parallel_heads'


def rms_norm(x, w, eps):
    xf = x.astype(jnp.float32)
    y = xf * lax.rsqrt(jnp.mean(xf * xf, axis=-1, keepdims=True) + eps)
    return (y * w.astype(jnp.float32)).astype(x.dtype)


def layer_norm(x, w, b, eps):
    xf = x.astype(jnp.float32)
    mu = jnp.mean(xf, axis=-1, keepdims=True)
    xc = xf - mu
    y = xc * lax.rsqrt(jnp.mean(xc * xc, axis=-1, keepdims=True) + eps)
    return (y * w.astype(jnp.float32) + b.astype(jnp.float32)).astype(x.dtype)


def rope_tables(positions, head_dim):
    rot = head_dim // ROPE_FRACTION
    inv = ROPE_THETA ** (-jnp.arange(0, rot, 2, dtype=jnp.float32) / rot)
    ang = positions.astype(jnp.float32)[:, None] * inv[None, :]
    return jnp.cos(ang), jnp.sin(ang)


def apply_rope(x, cos, sin):
    half = cos.shape[-1]
    shape = (1, x.shape[1]) + (1,) * (x.ndim - 3) + (half,)
    c = cos.reshape(shape)
    s = sin.reshape(shape)
    xf = x.astype(jnp.float32)
    x1 = xf[..., :half]
    x2 = xf[..., half:2 * half]
    out = jnp.concatenate([x1 * c - x2 * s, x2 * c + x1 * s, xf[..., 2 * half:]], axis=-1)
    return out.astype(x.dtype)


def diff_attention(q, k, v, lam):
    b, s, h = q.shape[0], q.shape[1], q.shape[2]
    e = v.shape[-1]
    n_blocks = s // Q_BLOCK
    scale = DIFF_QK_DIM ** -0.5
    qf = q.astype(jnp.float32)
    kf = k.astype(jnp.float32)
    vf = v.astype(jnp.float32)
    kpos = jnp.arange(s)

    def block(i):
        qb = lax.dynamic_slice_in_dim(qf, i * Q_BLOCK, Q_BLOCK, axis=1)
        qpos = i * Q_BLOCK + jnp.arange(Q_BLOCK)
        sc = jnp.einsum('bqhcd,bkhcd->bhcqk', qb, kf) * scale
        causal = kpos[None, :] <= qpos[:, None]
        sc = jnp.where(causal, sc, -jnp.inf)
        p = jax.nn.softmax(sc, axis=-1)
        attn = p[:, :, 0] - lam * p[:, :, 1]
        return jnp.einsum('bhqk,bkhe->bqhe', attn, vf)

    out = lax.map(block, jnp.arange(n_blocks))
    return out.transpose(1, 0, 2, 3, 4).reshape(b, s, h, e)


def dsa_attention(q, k, v, qi, ki, wi):
    b, s, h, d = q.shape
    n_sel = min(INDEX_TOPK, s // 4)
    n_blocks = s // Q_BLOCK
    scale = DSA_HEAD_DIM ** -0.5
    qf = q.astype(jnp.float32)
    kf = k.astype(jnp.float32)
    vf = v.astype(jnp.float32)
    qif = qi.astype(jnp.float32)
    kif = ki.astype(jnp.float32)
    wif = wi.astype(jnp.float32)
    kpos = jnp.arange(s)
    gather = jax.vmap(lambda arr, idx: arr[idx])

    def block(i):
        start = i * Q_BLOCK
        qb = lax.dynamic_slice_in_dim(qf, start, Q_BLOCK, axis=1)
        qib = lax.dynamic_slice_in_dim(qif, start, Q_BLOCK, axis=1)
        wib = lax.dynamic_slice_in_dim(wif, start, Q_BLOCK, axis=1)
        qpos = start + jnp.arange(Q_BLOCK)
        logits = jnp.einsum('bqhd,bkd->bqhk', qib, kif)
        score = jnp.einsum('bqhk,bqh->bqk', jax.nn.relu(logits), wib)
        causal = kpos[None, :] <= qpos[:, None]
        score = jnp.where(causal[None], score, -jnp.inf)
        _, idx = lax.top_k(score, n_sel)
        valid = idx <= qpos[None, :, None]
        k_sel = gather(kf, idx)
        v_sel = gather(vf, idx)
        sc = jnp.einsum('bqhd,bqkhd->bhqk', qb, k_sel) * scale
        sc = jnp.where(valid[:, None], sc, -jnp.inf)
        p = jax.nn.softmax(sc, axis=-1)
        return jnp.einsum('bhqk,bqkhd->bqhd', p, v_sel)

    out = lax.map(block, jnp.arange(n_blocks))
    return out.transpose(1, 0, 2, 3, 4).reshape(b, s, h, d)


def hybrid_layer(x, ropes, pre_w, post_w, w_in, w_out, lq1, lk1, lq2, lk2,
                 subln_w, ikn_w, ikn_b, lambda_init):
    (cos_d, sin_d), (cos_s, sin_s), (cos_i, sin_i) = ropes
    b, s, _ = x.shape
    h = rms_norm(x, pre_w, NORM_EPS)
    proj = jnp.einsum('bsd,dn->bsn', h, w_in)
    dq, dk, dv, dg, sq, sk, sv, sg, iq, ik, iw = jnp.split(proj, SPLIT_OFFSETS, axis=-1)

    dq = apply_rope(dq.reshape(b, s, DIFF_HEADS, 2, DIFF_QK_DIM), cos_d, sin_d)
    dk = apply_rope(dk.reshape(b, s, DIFF_HEADS, 2, DIFF_QK_DIM), cos_d, sin_d)
    dv = dv.reshape(b, s, DIFF_HEADS, DIFF_V_DIM)
    f32 = jnp.float32
    lam = (jnp.exp(jnp.sum(lq1.astype(f32) * lk1.astype(f32)))
           - jnp.exp(jnp.sum(lq2.astype(f32) * lk2.astype(f32))) + lambda_init)
    oa = diff_attention(dq, dk, dv, lam)
    oa = rms_norm(oa, subln_w, SUBLN_EPS) * (1.0 - lambda_init)
    oa = oa.reshape(b, s, DIFF_WIDTH).astype(x.dtype) * jax.nn.silu(dg)

    sq = apply_rope(sq.reshape(b, s, DSA_HEADS, DSA_HEAD_DIM), cos_s, sin_s)
    sk = apply_rope(sk.reshape(b, s, DSA_HEADS, DSA_HEAD_DIM), cos_s, sin_s)
    sv = sv.reshape(b, s, DSA_HEADS, DSA_HEAD_DIM)
    iq = apply_rope(iq.reshape(b, s, IDX_HEADS, IDX_DIM), cos_i, sin_i)
    ik = apply_rope(layer_norm(ik, ikn_w, ikn_b, LN_EPS), cos_i, sin_i)
    iw = iw * (IDX_HEADS ** -0.5 * IDX_DIM ** -0.5)
    ob = dsa_attention(sq, sk, sv, iq, ik, iw)
    ob = ob.reshape(b, s, DSA_WIDTH).astype(x.dtype) * jax.nn.silu(sg)

    mix = jnp.concatenate([oa, ob], axis=-1)
    y = jnp.einsum('bsm,md->bsd', mix, w_out)
    return x + rms_norm(y, post_w, NORM_EPS)


def setup_inputs(seed: int = 0) -> dict:
    key = jax.random.key(seed)
    ks = jax.random.split(key, 14)
    nrm = jax.random.normal
    f32 = jnp.float32
    return {
        'x': nrm(ks[0], (BATCH, SEQ, D_MODEL), f32),
        'positions': jnp.arange(SEQ, dtype=jnp.int32),
        'pre_norm_w': 1.0 + 0.02 * nrm(ks[1], (DEPTH, D_MODEL), f32),
        'post_norm_w': 1.0 + 0.02 * nrm(ks[2], (DEPTH, D_MODEL), f32),
        'w_in': nrm(ks[3], (DEPTH, D_MODEL, N_IN), f32) * D_MODEL ** -0.5,
        'w_out': nrm(ks[4], (DEPTH, D_MIX, D_MODEL), f32) * D_MIX ** -0.5,
        'lambda_q1': 0.1 * nrm(ks[5], (DEPTH, DIFF_QK_DIM), f32),
        'lambda_k1': 0.1 * nrm(ks[6], (DEPTH, DIFF_QK_DIM), f32),
        'lambda_q2': 0.1 * nrm(ks[7], (DEPTH, DIFF_QK_DIM), f32),
        'lambda_k2': 0.1 * nrm(ks[8], (DEPTH, DIFF_QK_DIM), f32),
        'diff_subln_w': 1.0 + 0.02 * nrm(ks[9], (DEPTH, DIFF_V_DIM), f32),
        'idx_k_norm_w': 1.0 + 0.02 * nrm(ks[10], (DEPTH, IDX_DIM), f32),
        'idx_k_norm_b': 0.02 * nrm(ks[11], (DEPTH, IDX_DIM), f32),
    }


def reference(x, positions, pre_norm_w, post_norm_w, w_in, w_out, lambda_q1, lambda_k1,
              lambda_q2, lambda_k2, diff_subln_w, idx_k_norm_w, idx_k_norm_b):
    ropes = (rope_tables(positions, DIFF_QK_DIM),
             rope_tables(positions, DSA_HEAD_DIM),
             rope_tables(positions, IDX_DIM))
    h = x
    for layer in range(DEPTH):
        lambda_init = 0.8 - 0.6 * math.exp(-0.3 * layer)
        h = hybrid_layer(h, ropes, pre_norm_w[layer], post_norm_w[layer], w_in[layer],
                         w_out[layer], lambda_q1[layer], lambda_k1[layer], lambda_q2[layer],
                         lambda_k2[layer], diff_subln_w[layer], idx_k_norm_w[layer],
                         idx_k_norm_b[layer], lambda_init)
    return h
```

```cpp
#include <hip/hip_runtime.h>
#ifndef PH_MASK
#define PH_MASK 127
#endif
#ifndef DBL_MASK
#define DBL_MASK 0
#endif
#include <cstdio>
#include <cstdint>

#define LAS __attribute__((address_space(3)))
typedef unsigned short bf16_t;
typedef short bf16x8 __attribute__((ext_vector_type(8)));
typedef short s16x4 __attribute__((ext_vector_type(4)));
typedef float f32x4 __attribute__((ext_vector_type(4)));
typedef float f32x16 __attribute__((ext_vector_type(16)));
typedef unsigned u32x4 __attribute__((ext_vector_type(4)));
typedef unsigned u32x2 __attribute__((ext_vector_type(2)));

constexpr int BATCH = 16, SEQ = 2048, DM = 1024, DEPTH = 4, NIN = 4680, NPAD = 4864, MTOK = BATCH * SEQ;
constexpr float LOG2E = 1.4426950408889634f;
constexpr size_t MiB = 1u << 20;
constexpr size_t WS_CTL = 0, WS_WIN = 1 * MiB, WS_WOUT = 39 * MiB, WS_TAB = 47 * MiB, WS_XB = 48 * MiB, WS_QMIX = 112 * MiB,
                 WS_DK = 176 * MiB, WS_DV = 208 * MiB, WS_Y = 176 * MiB  , WS_DG = 240 * MiB, WS_SK = 272 * MiB, WS_SV = 304 * MiB,
                 WS_SG = 336 * MiB, WS_IQ = 368 * MiB, WS_IK = 400 * MiB, WS_IW = 404 * MiB, WS_SEL = 405 * MiB, WS_END = 418 * MiB, WS_DUMMY = 420 * MiB  ;
constexpr size_t TB_CS64 = 0, TB_SN64 = 65536, TB_CS128 = 131072, TB_SN128 = 262144, TB_LAM = 393216, TB_RSTD = 397312;
constexpr int LDS_BYTES = 155648;

__device__ __forceinline__ unsigned f2bf(float f) { unsigned u = __builtin_bit_cast(unsigned, f); return (u + 0x7fffu + ((u >> 16) & 1u)) >> 16; }
typedef float f32x2 __attribute__((ext_vector_type(2))); typedef __bf16 bf16x2_t __attribute__((ext_vector_type(2)));
__device__ __forceinline__ unsigned pk2(float lo, float hi) { const f32x2 v = {lo, hi}; const bf16x2_t b = __builtin_convertvector(v, bf16x2_t); return __builtin_bit_cast(unsigned, b); }
__device__ __forceinline__ float bf2f(unsigned short h) { return __builtin_bit_cast(float, (unsigned)h << 16); }
__device__ __forceinline__ float bflo(unsigned w) { return __builtin_bit_cast(float, w << 16); }
__device__ __forceinline__ float bfhi(unsigned w) { return __builtin_bit_cast(float, w & 0xffff0000u); }
__device__ __forceinline__ float wave_sum(float v) {
#pragma unroll
    for (int o = 1; o < 64; o <<= 1) v += __shfl_xor(v, o);
    return v;
}

namespace pg8 {
constexpr int BM = 256, BK = 64, HALF = 128, HTB = HALF * BK * 2, STAGE_BYTES = 8 * HTB, NXCD = 8, WGM = 4;
__host__ __device__ __forceinline__ int lds_byte(int r, int c) { const int st = (r >> 4) * 2 + (c >> 5), rr = r & 15, cc = c & 31, ob = rr * 64 + cc * 2; return st * 1024 + (ob ^ (((ob >> 9) & 1) << 5)); }
__host__ __device__ __forceinline__ void stage_rc(int b, int& R, int& C) { const int st = b / 1024, sb = b % 1024, swz = sb ^ (((sb >> 9) & 1) << 5); R = (st >> 1) * 16 + swz / 64; C = (st & 1) * 32 + (swz % 64) / 2; }
__host__ __device__ __forceinline__ int perm32(int rho) { const int n = rho >> 4, i = rho & 15; return 8 * (i >> 2) + 4 * n + (i & 3); }
struct Unit { int pm, pn; };
struct Gemm { const bf16_t* A; const bf16_t* Bt; int M, N, K; };
struct StaticOrder {
    int nM, nN, nwg, G, c;
    __host__ __device__ void init(int M, int N, int G_, int c_) { nM = M / BM; nN = N / BM; nwg = nM * nN; G = G_; c = c_; }
    __host__ __device__ bool next(int i, Unit& u) const {
        const long L = (long)i * G + c; if (L >= nwg) return false;
        int wgid = (int)L; { const int q = nwg / NXCD, r = nwg % NXCD, xcd = wgid % NXCD, off = wgid / NXCD; wgid = (xcd < r ? xcd * (q + 1) : r * (q + 1) + (xcd - r) * q) + off; }
        const int nig = WGM * nN, gid = wgid / nig, fm = gid * WGM, gsz = (nM - fm) < WGM ? (nM - fm) : WGM;
        u.pm = fm + ((wgid % nig) % gsz); u.pn = (wgid % nig) / gsz; return true;
    }
    __device__ __forceinline__ void a_ready(const Unit&) const {}
    __device__ __forceinline__ void done(const Unit&) const {}
};
struct EpiBf16Plain {
    static constexpr bool PERM = true, AFTER_DRAIN = false, FUSED_LDS = false; static constexpr int HALF_B_TILE = -1;
    bf16_t* O; int ldc;
    __device__ __forceinline__ void operator()(const f32x4 (&acc)[2][2][4][2], const Unit& u, int wr, int wc, int fr, int fq) const {
        const int row0 = u.pm * BM + wr * 64 + fr; const int col0 = u.pn * BM + wc * 64 + 8 * fq;
#pragma unroll
        for (int ai = 0; ai < 2; ++ai)
#pragma unroll
            for (int m = 0; m < 4; ++m) { bf16_t* rowp = O + (size_t)(row0 + ai * HALF + m * 16) * ldc + col0;
#pragma unroll
                for (int bj = 0; bj < 2; ++bj) { const f32x4 v0 = acc[ai][bj][m][0], v1 = acc[ai][bj][m][1];
                    u32x4 w; w.x = pk2(v0[0], v0[1]); w.y = pk2(v0[2], v0[3]); w.z = pk2(v1[0], v1[1]); w.w = pk2(v1[2], v1[3]);
                    *(u32x4*)(rowp + bj * 32) = w; } }
    }
};

template <class Epi, class Sched, bool ALIGN_EPI = false, bool SP2 = false>
__device__ __forceinline__ void gemm_phase(LAS unsigned char* lds, const Gemm g, const Sched& S, const Epi& E, const int tid) {
    const int wid = __builtin_amdgcn_readfirstlane(tid >> 6), lane = tid & 63, wr = wid >> 2, wc = wid & 3, fr = lane & 15, fq = lane >> 4;
    const int K = g.K, nt = K / BK;
    unsigned voffA[2], voffB[2];
#pragma unroll
    for (int i = 0; i < 2; ++i) { int R, C; stage_rc(tid * 16 + i * 8192, R, C); const int Rb = 64 * (R >> 5) + perm32(R & 31);
        voffA[i] = (unsigned)(R * K + C) * 2u; voffB[i] = (unsigned)(Rb * K + C) * 2u; }
    const size_t kstep = (size_t)(BK * 2);
    const size_t hstep = (size_t)HALF * K * 2;
    const size_t hstepB = (size_t)32 * K * 2;
    const size_t tstep = 2 * hstep;
    const unsigned ldsw = (unsigned)wid * 1024u;
    const int aoff = lds_byte(wr * 64 + fr, fq * 8), boff = lds_byte(wc * 32 + fr, fq * 8);
#define PG8_SA(b, h) (((b) * 2 + (h)) * HTB)
#define PG8_SB(b, h) ((4 + (b) * 2 + (h)) * HTB)
#define PG8_STAGE(bufoff, gbase, voff) do { _Pragma("unroll") for (int _i = 0; _i < 2; ++_i) \
        __builtin_amdgcn_global_load_lds((const unsigned*)((const char*)(gbase) + (voff)[_i]), (LAS unsigned*)(lds + (bufoff) + ldsw + _i * 8192), 16, 0, 0); } while (0)
#define PG8_LDA(dst, b, h) do { _Pragma("unroll") for (int m = 0; m < 4; ++m) _Pragma("unroll") for (int k = 0; k < 2; ++k) dst[m][k] = *(const LAS bf16x8*)(lds + PG8_SA(b, h) + aoff + m * 2048 + k * 1024); } while (0)
#define PG8_LDB(dst, b, h) do { _Pragma("unroll") for (int n = 0; n < 2; ++n) _Pragma("unroll") for (int k = 0; k < 2; ++k) dst[n][k] = *(const LAS bf16x8*)(lds + PG8_SB(b, h) + boff + n * 2048 + k * 1024); } while (0)
#define PG8_MMA(ai, bj, At, Bt) do { __builtin_amdgcn_s_setprio(1); _Pragma("unroll") for (int m = 0; m < 4; ++m) _Pragma("unroll") for (int n = 0; n < 2; ++n) _Pragma("unroll") for (int k = 0; k < 2; ++k) \
        acc[ai][bj][m][n] = __builtin_amdgcn_mfma_f32_16x16x32_bf16(Bt[n][k], At[m][k], acc[ai][bj][m][n], 0, 0, 0); __builtin_amdgcn_s_setprio(0); } while (0)
#define PG8_WAIT_V(n) asm volatile("s_waitcnt vmcnt(" #n ")" ::: "memory")
#define PG8_WAIT_L(n) asm volatile("s_waitcnt lgkmcnt(" #n ")" ::: "memory")
#define PG8_BAR __builtin_amdgcn_s_barrier()
#define PG8_SCHED __builtin_amdgcn_sched_barrier(0)
    Unit cur, nxt; int ui = 0;
    if (!S.next(0, cur)) return;
    f32x4 acc[2][2][4][2];
#pragma unroll
    for (int a = 0; a < 2; ++a)
#pragma unroll
        for (int b = 0; b < 2; ++b)
#pragma unroll
            for (int m = 0; m < 4; ++m)
#pragma unroll
                for (int n = 0; n < 2; ++n) acc[a][b][m][n] = (f32x4){0.f, 0.f, 0.f, 0.f};
    bf16x8 At[4][2], B0[2][2], B1[2][2];
    const char* cA = (const char*)g.A + (size_t)cur.pm * tstep; const char* cB = (const char*)g.Bt + (size_t)cur.pn * tstep;
    S.a_ready(cur);
    if constexpr (SP2) {
        PG8_STAGE(PG8_SB(0, 0), cB, voffB); PG8_STAGE(PG8_SB(0, 1), cB + hstepB, voffB); PG8_STAGE(PG8_SA(0, 0), cA, voffA); PG8_STAGE(PG8_SA(0, 1), cA + hstep, voffA);
        if (wr == 1) PG8_BAR;
        PG8_WAIT_V(2); PG8_BAR;
        PG8_STAGE(PG8_SB(1, 0), cB + kstep, voffB); PG8_STAGE(PG8_SA(1, 0), cA + kstep, voffA); PG8_STAGE(PG8_SB(1, 1), cB + hstepB + kstep, voffB);
        PG8_WAIT_V(6); PG8_BAR;
    } else {
        PG8_STAGE(PG8_SB(0, 0), cB, voffB); PG8_STAGE(PG8_SA(0, 0), cA, voffA); PG8_STAGE(PG8_SB(0, 1), cB + hstepB, voffB); PG8_STAGE(PG8_SA(0, 1), cA + hstep, voffA);
        if (wr == 1) PG8_BAR;
        PG8_WAIT_V(4); PG8_BAR;
        PG8_STAGE(PG8_SB(1, 0), cB + kstep, voffB); PG8_STAGE(PG8_SA(1, 0), cA + kstep, voffA); PG8_STAGE(PG8_SB(1, 1), cB + hstepB + kstep, voffB);
        PG8_WAIT_V(6); PG8_BAR;
    }
    for (;;) {
        const bool has_next = S.next(ui + 1, nxt);
        const bool useB1 = (Epi::HALF_B_TILE < 0) || (cur.pn != Epi::HALF_B_TILE);
        const char* nA = has_next ? (const char*)g.A + (size_t)nxt.pm * tstep : cA; const char* nB = has_next ? (const char*)g.Bt + (size_t)nxt.pn * tstep : cB;
        for (int t = 0; t < nt; t += 2) {
            const bool last = (t == nt - 2);
            const char* a1 = cA + (size_t)(t + 1) * kstep;
            const char* a2 = last ? nA : cA + (size_t)(t + 2) * kstep; const char* b2 = last ? nB : cB + (size_t)(t + 2) * kstep;
            const char* a3 = a2 + kstep; const char* b3 = b2 + kstep;
            if (last && has_next) S.a_ready(nxt);
            if constexpr (SP2) {
            PG8_LDB(B0, 0, 0); if (useB1) PG8_LDB(B1, 0, 1); PG8_SCHED; PG8_LDA(At, 0, 0); PG8_STAGE(PG8_SA(1, 1), a1 + hstep, voffA);
            PG8_WAIT_V(8); PG8_WAIT_L(0); PG8_BAR; PG8_MMA(0, 0, At, B0); if (useB1) PG8_MMA(0, 1, At, B1); PG8_BAR; PG8_SCHED;
            PG8_LDA(At, 0, 1); PG8_STAGE(PG8_SB(0, 0), b2, voffB); PG8_STAGE(PG8_SB(0, 1), b2 + hstepB, voffB); PG8_STAGE(PG8_SA(0, 0), a2, voffA);
            PG8_WAIT_V(8); PG8_WAIT_L(0); PG8_BAR; PG8_MMA(1, 0, At, B0); if (useB1) PG8_MMA(1, 1, At, B1); PG8_BAR; PG8_SCHED;
            PG8_LDB(B0, 1, 0); if (useB1) PG8_LDB(B1, 1, 1); PG8_SCHED; PG8_LDA(At, 1, 0); PG8_STAGE(PG8_SA(0, 1), a2 + hstep, voffA);
            PG8_WAIT_V(8); PG8_WAIT_L(0); PG8_BAR; PG8_MMA(0, 0, At, B0); if (useB1) PG8_MMA(0, 1, At, B1); PG8_BAR; PG8_SCHED;
            PG8_LDA(At, 1, 1); PG8_STAGE(PG8_SB(1, 0), b3, voffB); PG8_STAGE(PG8_SB(1, 1), b3 + hstepB, voffB); PG8_STAGE(PG8_SA(1, 0), a3, voffA);
            PG8_WAIT_V(8); PG8_WAIT_L(0); PG8_BAR; PG8_MMA(1, 0, At, B0); if (useB1) PG8_MMA(1, 1, At, B1); PG8_BAR; PG8_SCHED;
            } else {
            PG8_LDB(B0, 0, 0); PG8_SCHED; PG8_LDA(At, 0, 0); PG8_STAGE(PG8_SA(1, 1), a1 + hstep, voffA);
            PG8_WAIT_L(8); PG8_BAR; PG8_WAIT_L(0); PG8_MMA(0, 0, At, B0); PG8_BAR; PG8_SCHED;
            PG8_LDB(B1, 0, 1); PG8_STAGE(PG8_SB(0, 0), b2, voffB);
            PG8_BAR; PG8_WAIT_L(0); PG8_MMA(0, 1, At, B1); PG8_BAR;
            PG8_LDA(At, 0, 1); PG8_STAGE(PG8_SA(0, 0), a2, voffA);
            PG8_BAR; PG8_WAIT_L(0); PG8_MMA(1, 0, At, B0); PG8_BAR; PG8_SCHED;
            PG8_STAGE(PG8_SB(0, 1), b2 + hstepB, voffB);
            PG8_WAIT_V(6); PG8_BAR; PG8_MMA(1, 1, At, B1); PG8_BAR;
            PG8_LDB(B0, 1, 0); PG8_SCHED; PG8_LDA(At, 1, 0); PG8_STAGE(PG8_SA(0, 1), a2 + hstep, voffA);
            PG8_WAIT_L(8); PG8_BAR; PG8_WAIT_L(0); PG8_MMA(0, 0, At, B0); PG8_BAR; PG8_SCHED;
            PG8_LDB(B1, 1, 1); PG8_STAGE(PG8_SB(1, 0), b3, voffB);
            PG8_BAR; PG8_WAIT_L(0); PG8_MMA(0, 1, At, B1); PG8_BAR;
            PG8_LDA(At, 1, 1); PG8_STAGE(PG8_SA(1, 0), a3, voffA);
            PG8_BAR; PG8_WAIT_L(0); PG8_MMA(1, 0, At, B0); PG8_BAR; PG8_SCHED;
            PG8_STAGE(PG8_SB(1, 1), b3 + hstepB, voffB);
            PG8_WAIT_V(6); PG8_BAR; PG8_MMA(1, 1, At, B1); PG8_BAR;
            }
        }
        if constexpr (ALIGN_EPI) { if (wr == 0) PG8_BAR; }
        if constexpr (Epi::FUSED_LDS) { E.fused(acc, cur, wr, wc, fr, fq, lds + STAGE_BYTES, wid, lane); S.done(cur); }
        else if constexpr (!Epi::AFTER_DRAIN) { E(acc, cur, wr, wc, fr, fq); S.done(cur); }
        if (!has_next) break;
#pragma unroll
        for (int a = 0; a < 2; ++a)
#pragma unroll
            for (int b = 0; b < 2; ++b)
#pragma unroll
                for (int m = 0; m < 4; ++m)
#pragma unroll
                    for (int n = 0; n < 2; ++n) acc[a][b][m][n] = (f32x4){0.f, 0.f, 0.f, 0.f};
        cur = nxt; cA = nA; cB = nB; ++ui;
        if constexpr (ALIGN_EPI) { if (wr == 1) PG8_BAR; }
    }
    PG8_WAIT_V(0);
    if constexpr (!ALIGN_EPI) { if (wr == 0) PG8_BAR; }
    PG8_BAR;
#undef PG8_SA
#undef PG8_SB
#undef PG8_STAGE
#undef PG8_LDA
#undef PG8_LDB
#undef PG8_MMA
#undef PG8_WAIT_V
#undef PG8_WAIT_L
#undef PG8_BAR
#undef PG8_SCHED
}
}

struct EpiInProj {
    static constexpr bool PERM = true, AFTER_DRAIN = false, FUSED_LDS = true; static constexpr int HALF_B_TILE = 18;
    unsigned char* ws; const float *iknw, *iknb;
    template <int KIND>
    __device__ __forceinline__ void tile(const f32x4 (&acc)[2][2][4][2], size_t wsoff, int ldc, int colt, float sc, int row0, int wc, int fq) const {
        bf16_t* base = (bf16_t*)(ws + wsoff);
        const float* rstd = (const float*)(ws + WS_TAB + TB_RSTD);
        const float* ctab = (const float*)(ws + WS_TAB + (KIND == 2 ? TB_CS128 : TB_CS64)); const float* stab = (const float*)(ws + WS_TAB + (KIND == 2 ? TB_SN128 : TB_SN64));
        constexpr bool ROPE = (KIND == 1 || KIND == 2);
        const bool rot = (KIND == 1) ? true : (KIND == 2 ? ((wc & 1) == 0) : false);
        float rs8[8];
#pragma unroll
        for (int g = 0; g < 8; ++g) rs8[g] = rstd[row0 + (g >> 2) * 128 + (g & 3) * 16];
        f32x4 c0, c1, s0, s1;
        const int tstride = (KIND == 2) ? 16 : 8, toff = (KIND == 2) ? 8 * (fq & 1) : 0;
        if (ROPE && rot) { const int o = (row0 & (SEQ - 1)) * tstride + toff; c0 = *(const f32x4*)(ctab + o); c1 = *(const f32x4*)(ctab + o + 4); s0 = *(const f32x4*)(stab + o); s1 = *(const f32x4*)(stab + o + 4); }
#pragma unroll
        for (int g = 0; g < 8; ++g) {
            const int ai = g >> 2, m = g & 3;
            const int row = row0 + ai * 128 + m * 16; const float rs = rs8[g] * sc;
            f32x4 v[2][2];
#pragma unroll
            for (int bj = 0; bj < 2; ++bj) { v[bj][0] = acc[ai][bj][m][0] * rs; v[bj][1] = acc[ai][bj][m][1] * rs; }
            if (ROPE && rot) {
                const bool neg = (KIND == 1) ? (fq == 0) : (fq < 2); const bool idn = (KIND == 1) && (fq >= 2);
                const f32x4 cc0 = idn ? (f32x4){1.f, 1.f, 1.f, 1.f} : c0, cc1 = idn ? (f32x4){1.f, 1.f, 1.f, 1.f} : c1;
                const f32x4 ss0 = idn ? (f32x4){0.f, 0.f, 0.f, 0.f} : (neg ? -s0 : s0), ss1 = idn ? (f32x4){0.f, 0.f, 0.f, 0.f} : (neg ? -s1 : s1);
                {
                    f32x4 p0, p1;
#pragma unroll
                    for (int e = 0; e < 4; ++e) { p0[e] = __shfl_xor(v[0][0][e], KIND == 1 ? 16 : 32); p1[e] = __shfl_xor(v[0][1][e], KIND == 1 ? 16 : 32); }
                    v[0][0] = v[0][0] * cc0 + p0 * ss0; v[0][1] = v[0][1] * cc1 + p1 * ss1;
                }
                if (g < 7) { const int rn = row0 + ((g + 1) >> 2) * 128 + ((g + 1) & 3) * 16; const int o = (rn & (SEQ - 1)) * tstride + toff;
                    c0 = *(const f32x4*)(ctab + o); c1 = *(const f32x4*)(ctab + o + 4); s0 = *(const f32x4*)(stab + o); s1 = *(const f32x4*)(stab + o + 4); }
            }
            const unsigned roff = (unsigned)(row * ldc + colt + wc * 64 + 8 * fq) * 2u;
#pragma unroll
            for (int bj = 0; bj < 2; ++bj) {
                f32x4 v0 = v[bj][0], v1 = v[bj][1];
                if (KIND == 3) {
#pragma unroll
                    for (int e = 0; e < 4; ++e) { v0[e] = v0[e] * __builtin_amdgcn_rcpf(1.f + __builtin_amdgcn_exp2f(-LOG2E * v0[e])); v1[e] = v1[e] * __builtin_amdgcn_rcpf(1.f + __builtin_amdgcn_exp2f(-LOG2E * v1[e])); }
                }
                u32x4 w; w.x = pk2(v0[0], v0[1]); w.y = pk2(v0[2], v0[3]); w.z = pk2(v1[0], v1[1]); w.w = pk2(v1[2], v1[3]);
                *(u32x4*)((unsigned char*)base + roff + bj * 64) = w;
            }
            asm volatile("" ::: "memory");
        }
    }
    __device__ __forceinline__ void fused(f32x4 (&acc)[2][2][4][2], const pg8::Unit& u, int wr, int wc, int fr_, int fq_, LAS unsigned char* scr, int wid, int lane) const {
        int fr = fr_, fq = fq_; asm volatile("" : "+v"(fr), "+v"(fq));
        const int pn = u.pn;
        const int row0 = u.pm * 256 + wr * 64 + fr;
        if (pn < 18) {
            const int grp = pn >> 1; const int colt = (pn & 1) * 256;
            switch (grp) {
                case 0: tile<1>(acc, WS_QMIX, 1024, colt, 0.125f * LOG2E, row0, wc, fq); break;
                case 1: tile<1>(acc, WS_DK, 512, colt, 1.f, row0, wc, fq); break;
                case 2: tile<0>(acc, WS_DV, 512, colt, 1.f, row0, wc, fq); break;
                case 3: tile<3>(acc, WS_DG, 512, colt, 1.f, row0, wc, fq); break;
                case 4: tile<2>(acc, WS_QMIX, 1024, colt + 512, 0.08838834764831845f * LOG2E, row0, wc, fq); break;
                case 5: tile<2>(acc, WS_SK, 512, colt, 1.f, row0, wc, fq); break;
                case 6: tile<0>(acc, WS_SV, 512, colt, 1.f, row0, wc, fq); break;
                case 7: tile<3>(acc, WS_SG, 512, colt, 1.f, row0, wc, fq); break;
                default: tile<1>(acc, WS_IQ, 512, colt, 1.f, row0, wc, fq); break;
            }
        } else {
            const float* rstd = (const float*)(ws + WS_TAB + TB_RSTD); const float* cs64 = (const float*)(ws + WS_TAB + TB_CS64); const float* sn64 = (const float*)(ws + WS_TAB + TB_SN64);
            bf16_t* IK = (bf16_t*)(ws + WS_IK); float* IW = (float*)(ws + WS_IW);
            LAS float* T = (LAS float*)scr;
            float rs8[8];
#pragma unroll
            for (int g = 0; g < 8; ++g) rs8[g] = rstd[row0 + (g >> 2) * 128 + (g & 3) * 16];
            if (wc < 2) {
#pragma unroll
                for (int g = 0; g < 8; ++g) { const int ai = g >> 2, m = g & 3; const f32x4 v0 = acc[ai][0][m][0] * rs8[g], v1 = acc[ai][0][m][1] * rs8[g];
                    float s = (v0[0] + v0[1]) + (v0[2] + v0[3]) + (v1[0] + v1[1]) + (v1[2] + v1[3]);
                    float q = (v0[0] * v0[0] + v0[1] * v0[1]) + (v0[2] * v0[2] + v0[3] * v0[3]) + (v1[0] * v1[0] + v1[1] * v1[1]) + (v1[2] * v1[2] + v1[3] * v1[3]);
                    s += __shfl_xor(s, 16); s += __shfl_xor(s, 32); q += __shfl_xor(q, 16); q += __shfl_xor(q, 32);
                    if (fq == 0) { const int lr = ai * 128 + wr * 64 + m * 16 + fr; T[(lr * 2 + wc) * 2] = s; T[(lr * 2 + wc) * 2 + 1] = q; } }
            }
            asm volatile("s_waitcnt lgkmcnt(0)" ::: "memory"); __builtin_amdgcn_s_barrier(); asm volatile("" ::: "memory");
            if (wc < 2) {
                const f32x4 w0 = *(const f32x4*)(iknw + 32 * wc + 8 * fq), w1 = *(const f32x4*)(iknw + 32 * wc + 8 * fq + 4), b0 = *(const f32x4*)(iknb + 32 * wc + 8 * fq), b1 = *(const f32x4*)(iknb + 32 * wc + 8 * fq + 4);
#pragma unroll
                for (int g = 0; g < 8; ++g) { const int ai = g >> 2, m = g & 3; const int lr = ai * 128 + wr * 64 + m * 16 + fr; const int row = u.pm * 256 + lr; const int sp = row & (SEQ - 1);
                    const float s = T[lr * 4] + T[lr * 4 + 2], q = T[lr * 4 + 1] + T[lr * 4 + 3];
                    const float mu = s * (1.f / 64.f), var = fmaxf(q * (1.f / 64.f) - mu * mu, 0.f), rsd = rsqrtf(var + 1e-6f);
                    f32x4 v0 = (acc[ai][0][m][0] * rs8[g] - mu) * rsd * w0 + b0, v1 = (acc[ai][0][m][1] * rs8[g] - mu) * rsd * w1 + b1;
                    if (wc == 0) {
                        const f32x4 c0 = *(const f32x4*)(cs64 + sp * 8), c1 = *(const f32x4*)(cs64 + sp * 8 + 4), s0 = *(const f32x4*)(sn64 + sp * 8), s1 = *(const f32x4*)(sn64 + sp * 8 + 4);
                        f32x4 p0, p1;
#pragma unroll
                        for (int e = 0; e < 4; ++e) { p0[e] = __shfl_xor(v0[e], 16); p1[e] = __shfl_xor(v1[e], 16); }
                        if (fq == 0) { v0 = v0 * c0 - p0 * s0; v1 = v1 * c1 - p1 * s1; }
                        else if (fq == 1) { v0 = v0 * c0 + p0 * s0; v1 = v1 * c1 + p1 * s1; }
                    }
                    u32x4 w; w.x = pk2(v0[0], v0[1]); w.y = pk2(v0[2], v0[3]); w.z = pk2(v1[0], v1[1]); w.w = pk2(v1[2], v1[3]);
                    *(u32x4*)(IK + (size_t)row * 64 + 32 * wc + 8 * fq) = w;
                    asm volatile("" ::: "memory"); }
            } else if (wc == 2) {
                if (fq == 0) {
#pragma unroll
                    for (int g = 0; g < 8; ++g) { const int ai = g >> 2, m = g & 3; const int row = row0 + ai * 128 + m * 16; const float rs = rs8[g] * 0.04419417382415922f;
                        *(f32x4*)(IW + (size_t)row * 8) = acc[ai][0][m][0] * rs; *(f32x4*)(IW + (size_t)row * 8 + 4) = acc[ai][0][m][1] * rs; }
                }
            }
            asm volatile("s_waitcnt lgkmcnt(0)" ::: "memory"); __builtin_amdgcn_s_barrier(); asm volatile("" ::: "memory");
        }
    }
};

constexpr int CW_XCNT = 16384;
constexpr size_t WS_XSLOT = 413 * MiB;
struct EpiOutNorm {
    static constexpr bool PERM = true, AFTER_DRAIN = false, FUSED_LDS = true; static constexpr int HALF_B_TILE = -1;
    unsigned char* ws; const float* post_w; float* out; int layer; bool last;
    __device__ __forceinline__ void exchange(const float (&part)[8], int e, const pg8::Unit& u, int wr, int wc, int fr, int fq, LAS unsigned char* scr, int wid, int lane, float scale_eps_unused) const {
        LAS float* Pt = (LAS float*)scr;
        LAS float* St = (LAS float*)(scr + 4096);
        float* slots = (float*)(ws + WS_XSLOT) + (size_t)(layer * 2 + e) * MTOK * 4;
        unsigned* cnt = (unsigned*)(ws + WS_CTL) + CW_XCNT + ((layer * 2 + e) * 128 + u.pm) * 64;
#pragma unroll
        for (int g = 0; g < 8; ++g) { float q = part[g]; q += __shfl_xor(q, 16); q += __shfl_xor(q, 32); if (fq == 0) Pt[((g >> 2) * 128 + wr * 64 + (g & 3) * 16 + fr) * 4 + wc] = q; }
        asm volatile("s_waitcnt lgkmcnt(0)" ::: "memory"); __builtin_amdgcn_s_barrier(); asm volatile("" ::: "memory");
        const int row = wid * 32 + (lane & 31);
        if (lane < 32) { const float t = (Pt[row * 4 + 0] + Pt[row * 4 + 1]) + (Pt[row * 4 + 2] + Pt[row * 4 + 3]);
            __hip_atomic_store(slots + ((size_t)(u.pm * 256 + row) * 4 + u.pn), t, __ATOMIC_RELAXED, __HIP_MEMORY_SCOPE_AGENT); }
        asm volatile("s_waitcnt vmcnt(0)" ::: "memory");
        if (lane == 0) __hip_atomic_fetch_add(cnt, 1u, __ATOMIC_RELAXED, __HIP_MEMORY_SCOPE_AGENT);
        if (wid == 0) {
            unsigned sp = 0;
            while ((unsigned)__builtin_amdgcn_readfirstlane((int)__hip_atomic_load(cnt, __ATOMIC_RELAXED, __HIP_MEMORY_SCOPE_AGENT)) < 32u) { __builtin_amdgcn_s_sleep(2); if (++sp > (1u << 22)) break; }
            __builtin_amdgcn_fence(__ATOMIC_ACQUIRE, "agent");
        }
        asm volatile("s_waitcnt vmcnt(0) lgkmcnt(0)" ::: "memory"); __builtin_amdgcn_s_barrier(); asm volatile("" ::: "memory");
        if (lane < 32) { const float* sl = slots + (size_t)(u.pm * 256 + row) * 4; float t = 0.f;
#pragma unroll
            for (int k = 0; k < 4; ++k) t += __hip_atomic_load(sl + k, __ATOMIC_RELAXED, __HIP_MEMORY_SCOPE_AGENT);
            St[row] = t; }
        asm volatile("s_waitcnt vmcnt(0) lgkmcnt(0)" ::: "memory"); __builtin_amdgcn_s_barrier(); asm volatile("" ::: "memory");
    }
    __device__ __forceinline__ void fused(f32x4 (&acc)[2][2][4][2], const pg8::Unit& u, int wr, int wc, int fr_, int fq_, LAS unsigned char* scr, int wid, int lane) const {
        int fr = fr_, fq = fq_; asm volatile("" : "+v"(fr), "+v"(fq));
        LAS float* St = (LAS float*)(scr + 4096);
        bf16_t* XB = (bf16_t*)(ws + WS_XB); float* RSTD = (float*)(ws + WS_TAB + TB_RSTD);
        const int row0 = u.pm * 256 + wr * 64 + fr; const int col0 = u.pn * 256 + wc * 64 + 8 * fq;
        u32x4 xr[4][2];
#pragma unroll
        for (int g = 0; g < 4; ++g)
#pragma unroll
            for (int bj = 0; bj < 2; ++bj) xr[g][bj] = *(const u32x4*)(XB + (size_t)(row0 + (g >> 2) * 128 + (g & 3) * 16) * DM + col0 + bj * 32);
        f32x4 pw[2][2];
#pragma unroll
        for (int bj = 0; bj < 2; ++bj)
#pragma unroll
            for (int n = 0; n < 2; ++n) pw[bj][n] = *(const f32x4*)(post_w + col0 + bj * 32 + 4 * n);
        float part[8];
#pragma unroll
        for (int g = 0; g < 8; ++g) { const int ai = g >> 2, m = g & 3; float q = 0.f;
#pragma unroll
            for (int bj = 0; bj < 2; ++bj)
#pragma unroll
                for (int n = 0; n < 2; ++n) { const f32x4 v = acc[ai][bj][m][n]; q += (v[0] * v[0] + v[1] * v[1]) + (v[2] * v[2] + v[3] * v[3]); }
            part[g] = q; }
        exchange(part, 0, u, wr, wc, fr, fq, scr, wid, lane, 0.f);
#pragma unroll
        for (int g = 0; g < 8; ++g) { const int ai = g >> 2, m = g & 3; const int lr = ai * 128 + wr * 64 + m * 16 + fr;
            const float ry = rsqrtf(St[lr] * (1.f / DM) + 1e-6f); float q = 0.f;
#pragma unroll
            for (int bj = 0; bj < 2; ++bj) { const u32x4 xv = xr[g & 3][bj];
                f32x4 x0 = (f32x4){bflo(xv.x), bfhi(xv.x), bflo(xv.y), bfhi(xv.y)}, x1 = (f32x4){bflo(xv.z), bfhi(xv.z), bflo(xv.w), bfhi(xv.w)};
                x0 = x0 + acc[ai][bj][m][0] * ry * pw[bj][0]; x1 = x1 + acc[ai][bj][m][1] * ry * pw[bj][1];
                acc[ai][bj][m][0] = x0; acc[ai][bj][m][1] = x1;
                q += (x0[0] * x0[0] + x0[1] * x0[1]) + (x0[2] * x0[2] + x0[3] * x0[3]) + (x1[0] * x1[0] + x1[1] * x1[1]) + (x1[2] * x1[2] + x1[3] * x1[3]); }
            part[g] = q;
            if (g < 4) {
#pragma unroll
                for (int bj = 0; bj < 2; ++bj) xr[g][bj] = *(const u32x4*)(XB + (size_t)(row0 + 128 + g * 16) * DM + col0 + bj * 32);
            } }
        if (last) {
#pragma unroll
            for (int g = 0; g < 8; ++g) { const int ai = g >> 2, m = g & 3; const size_t off = (size_t)(row0 + ai * 128 + m * 16) * DM + col0;
#pragma unroll
                for (int bj = 0; bj < 2; ++bj) { *(f32x4*)(out + off + bj * 32) = acc[ai][bj][m][0]; *(f32x4*)(out + off + bj * 32 + 4) = acc[ai][bj][m][1]; } }
        } else {
            exchange(part, 1, u, wr, wc, fr, fq, scr, wid, lane, 0.f);
            if (u.pn == 0 && lane < 32) { const int row = wid * 32 + lane; RSTD[u.pm * 256 + row] = rsqrtf(St[row] * (1.f / DM) + 1e-6f); }
#pragma unroll
            for (int g = 0; g < 8; ++g) { const int ai = g >> 2, m = g & 3; const size_t off = (size_t)(row0 + ai * 128 + m * 16) * DM + col0;
#pragma unroll
                for (int bj = 0; bj < 2; ++bj) { const f32x4 v0 = acc[ai][bj][m][0], v1 = acc[ai][bj][m][1];
                    u32x4 w; w.x = pk2(v0[0], v0[1]); w.y = pk2(v0[2], v0[3]); w.z = pk2(v1[0], v1[1]); w.w = pk2(v1[2], v1[3]);
                    *(u32x4*)(XB + off + bj * 32) = w; } }
        }
    }
};

struct Params {
    const float* x; const int* positions; const float* pre_w; const float* post_w; const float* w_in; const float* w_out;
    const float *lq1, *lk1, *lq2, *lk2; const float* subln_w; const float* iknw; const float* iknb;
    float* out; unsigned char* ws;
};

__device__ __forceinline__ int win_src(int n) {
    if (n < 4608) return n;
    const int p = n - 4608;
    if (p < 32) return 4608 + p;
    if (p >= 64 && p < 96) return 4608 + 32 + (p - 64);
    if (p >= 128 && p < 136) return 4672 + (p - 128);
    return -1;
}

__device__ __forceinline__ void transpose_item(const float* W, int ldw, const float* scale  , bool mapped, bf16_t* WT, LAS float* scr, int kb, int nb, int lane) {
    const int k0 = 64 * kb, n0 = 32 * nb;
    const int src = mapped ? win_src(n0 + (lane & 31)) : n0 + (lane & 31);
    float v[32];
#pragma unroll
    for (int i = 0; i < 32; ++i) { const int kk = 2 * i + (lane >> 5); v[i] = (src >= 0) ? W[(size_t)(k0 + kk) * ldw + src] : 0.f; }
#pragma unroll
    for (int i = 0; i < 32; ++i) scr[(2 * i + (lane >> 5)) * 33 + (lane & 31)] = v[i];
    asm volatile("s_waitcnt lgkmcnt(0)" ::: "memory");
    const int c = lane & 7;
    f32x4 s0 = (f32x4){1.f, 1.f, 1.f, 1.f}, s1 = s0;
    if (scale) { s0 = *(const f32x4*)(scale + k0 + 8 * c); s1 = *(const f32x4*)(scale + k0 + 8 * c + 4); }
#pragma unroll
    for (int j = 0; j < 4; ++j) { const int n = (lane >> 3) + 8 * j; const LAS float* s = scr + (8 * c) * 33 + n;
        u32x4 o; o.x = pk2(s[0 * 33] * s0[0], s[1 * 33] * s0[1]); o.y = pk2(s[2 * 33] * s0[2], s[3 * 33] * s0[3]); o.z = pk2(s[4 * 33] * s1[0], s[5 * 33] * s1[1]); o.w = pk2(s[6 * 33] * s1[2], s[7 * 33] * s1[3]);
        *(u32x4*)(WT + (size_t)(n0 + n) * 1024 + k0 + 8 * c) = o; }
    asm volatile("s_waitcnt lgkmcnt(0)" ::: "memory");
}

__device__ __forceinline__ void convert_weights(const Params& P, LAS float* scr, int l0, int l1, int w, int nw, int lane) {
    bf16_t* WIN = (bf16_t*)(P.ws + WS_WIN); bf16_t* WOUT = (bf16_t*)(P.ws + WS_WOUT);
    constexpr int I_IN = 16 * (NPAD / 32), I_OUT = 16 * 32, I_L = I_IN + I_OUT;
    for (int it = w; it < (l1 - l0) * I_L; it += nw) {
        const int l = l0 + it / I_L, r = it % I_L;
        if (r < I_IN) transpose_item(P.w_in + (size_t)l * DM * NIN, NIN, P.pre_w + l * DM, true, WIN + (size_t)l * NPAD * DM, scr, r / (NPAD / 32), r % (NPAD / 32), lane);
        else { const int r2 = r - I_IN; transpose_item(P.w_out + (size_t)l * DM * DM, DM, nullptr, false, WOUT + (size_t)l * DM * DM, scr, r2 / 32, r2 % 32, lane); }
    }
}

__device__ __forceinline__ void prep_phase(const Params& P, LAS unsigned char* lds, int tid, int lane, int wave) {
    const int G = gridDim.x; const int gw = blockIdx.x * 8 + wave, NGW = G * 8;
    LAS float* scr = (LAS float*)(lds + wave * 16384);
    bf16_t* XB = (bf16_t*)(P.ws + WS_XB); float* RSTD = (float*)(P.ws + WS_TAB + TB_RSTD);
#pragma unroll 1
    for (int job = 0; job < 2; ++job) {
      if ((job ^ (int)(blockIdx.x & 1)) == 0) {
    convert_weights(P, scr, 0, 1, gw, NGW, lane);
      } else {
    for (int m0 = 4 * gw; m0 < MTOK; m0 += 4 * NGW) {
        f32x4 v[4][4]; float ss[4];
#pragma unroll
        for (int r = 0; r < 4; ++r) { const f32x4* xr = (const f32x4*)(P.x + (size_t)(m0 + r) * DM) + lane;
#pragma unroll
            for (int j = 0; j < 4; ++j) v[r][j] = xr[64 * j]; }
#pragma unroll
        for (int r = 0; r < 4; ++r) { float s = 0.f;
#pragma unroll
            for (int j = 0; j < 4; ++j) s += (v[r][j][0] * v[r][j][0] + v[r][j][1] * v[r][j][1]) + (v[r][j][2] * v[r][j][2] + v[r][j][3] * v[r][j][3]);
            ss[r] = s; }
#pragma unroll
        for (int o = 1; o < 64; o <<= 1) {
#pragma unroll
            for (int r = 0; r < 4; ++r) ss[r] += __shfl_xor(ss[r], o); }
#pragma unroll
        for (int r = 0; r < 4; ++r) { u32x2* o = (u32x2*)(XB + (size_t)(m0 + r) * DM) + lane;
#pragma unroll
            for (int j = 0; j < 4; ++j) { u32x2 w; w.x = pk2(v[r][j][0], v[r][j][1]); w.y = pk2(v[r][j][2], v[r][j][3]); o[64 * j] = w; }
            if (lane == 0) RSTD[m0 + r] = rsqrtf(ss[r] * (1.f / DM) + 1e-6f); }
    }
      }
    }
    float* cs64 = (float*)(P.ws + WS_TAB + TB_CS64); float* sn64 = (float*)(P.ws + WS_TAB + TB_SN64);
    float* cs128 = (float*)(P.ws + WS_TAB + TB_CS128); float* sn128 = (float*)(P.ws + WS_TAB + TB_SN128);
    for (int idx = blockIdx.x * 512 + tid; idx < SEQ * 16; idx += G * 512) {
        const int s = idx >> 4, i = idx & 15; const float pos = (float)P.positions[s];
        { const float inv = powf(500000.0f, -(float)(2 * i) / 32.0f); const float a = pos * inv; cs128[idx] = cosf(a); sn128[idx] = sinf(a); }
        if (i < 8) { const float inv = powf(500000.0f, -(float)(2 * i) / 16.0f); const float a = pos * inv; cs64[s * 8 + i] = cosf(a); sn64[s * 8 + i] = sinf(a); }
    }
    if (blockIdx.x == 0 && wave == 0) {
        float* lam = (float*)(P.ws + WS_TAB + TB_LAM);
        for (int l = 0; l < DEPTH; ++l) {
            const float d1 = wave_sum(P.lq1[l * 64 + lane] * P.lk1[l * 64 + lane]), d2 = wave_sum(P.lq2[l * 64 + lane] * P.lk2[l * 64 + lane]);
            const float li = 0.8f - 0.6f * expf(-0.3f * (float)l);
            if (lane == 0) { lam[2 * l] = expf(d1) - expf(d2) + li; lam[2 * l + 1] = li; }
        }
    }
}

__device__ __forceinline__ void norm_phase(const Params& P, int layer_done  , bool last, int lane, int wave) {
    const int G = gridDim.x; const int gw = blockIdx.x * 8 + wave, NGW = G * 8;
    bf16_t* XB = (bf16_t*)(P.ws + WS_XB); const bf16_t* Y = (const bf16_t*)(P.ws + WS_Y); float* RSTD = (float*)(P.ws + WS_TAB + TB_RSTD);
    const float* pw = P.post_w + layer_done * DM;
    f32x4 w4[4];
#pragma unroll
    for (int i = 0; i < 2; ++i) { w4[2 * i] = *(const f32x4*)(pw + 8 * lane + 512 * i); w4[2 * i + 1] = *(const f32x4*)(pw + 8 * lane + 512 * i + 4); }
    for (int m = gw; m < MTOK; m += NGW) {
        u32x4 yv[2], xv[2];
#pragma unroll
        for (int i = 0; i < 2; ++i) { yv[i] = *(const u32x4*)(Y + (size_t)m * DM + 8 * lane + 512 * i); xv[i] = *(const u32x4*)(XB + (size_t)m * DM + 8 * lane + 512 * i); }
        float yf[16], xf[16]; float s = 0.f;
#pragma unroll
        for (int i = 0; i < 2; ++i)
#pragma unroll
            for (int e = 0; e < 4; ++e) { yf[8 * i + 2 * e] = bflo(yv[i][e]); yf[8 * i + 2 * e + 1] = bfhi(yv[i][e]); xf[8 * i + 2 * e] = bflo(xv[i][e]); xf[8 * i + 2 * e + 1] = bfhi(xv[i][e]); }
#pragma unroll
        for (int k = 0; k < 16; ++k) s += yf[k] * yf[k];
        s = wave_sum(s);
        const float ry = rsqrtf(s * (1.f / DM) + 1e-6f);
        float s2 = 0.f;
#pragma unroll
        for (int k = 0; k < 16; ++k) { xf[k] = xf[k] + yf[k] * ry * w4[k >> 2][k & 3]; s2 += xf[k] * xf[k]; }
        if (last) {
#pragma unroll
            for (int i = 0; i < 2; ++i) { float* o = P.out + (size_t)m * DM + 8 * lane + 512 * i;
                *(f32x4*)o = (f32x4){xf[8 * i], xf[8 * i + 1], xf[8 * i + 2], xf[8 * i + 3]}; *(f32x4*)(o + 4) = (f32x4){xf[8 * i + 4], xf[8 * i + 5], xf[8 * i + 6], xf[8 * i + 7]}; }
        } else {
            s2 = wave_sum(s2);
#pragma unroll
            for (int i = 0; i < 2; ++i) { u32x4 w; w.x = pk2(xf[8 * i], xf[8 * i + 1]); w.y = pk2(xf[8 * i + 2], xf[8 * i + 3]); w.z = pk2(xf[8 * i + 4], xf[8 * i + 5]); w.w = pk2(xf[8 * i + 6], xf[8 * i + 7]);
                *(u32x4*)(XB + (size_t)m * DM + 8 * lane + 512 * i) = w; }
            if (lane == 0) RSTD[m] = rsqrtf(s2 * (1.f / DM) + 1e-6f);
        }
    }
}

constexpr int SC_PITCH = 2052;
__device__ __forceinline__ unsigned sortable(float v) { v = v + 0.0f; const unsigned u = __builtin_bit_cast(unsigned, v); return (u & 0x80000000u) ? ~u : (u | 0x80000000u); }

template <int NJ>
__device__ __forceinline__ int count_ge(const unsigned (&u)[NJ], unsigned cand) {
    static_assert(NJ % 4 == 0, "count_ge: NJ is a multiple of 4");
    unsigned c0 = 0u, c1 = 0u, c2 = 0u, c3 = 0u;
#pragma unroll
    for (int j = 0; j < NJ; j += 4) {
        unsigned long long t0, t1, t2, t3;
        asm volatile("v_cmp_le_u32_e64 %4, %8, %9\n\tv_cmp_le_u32_e64 %5, %8, %10\n\tv_cmp_le_u32_e64 %6, %8, %11\n\tv_cmp_le_u32_e64 %7, %8, %12\n\t"
                     "v_addc_co_u32_e64 %0, %4, 0, %0, %4\n\tv_addc_co_u32_e64 %1, %5, 0, %1, %5\n\tv_addc_co_u32_e64 %2, %6, 0, %2, %6\n\tv_addc_co_u32_e64 %3, %7, 0, %3, %7"
                     : "+v"(c0), "+v"(c1), "+v"(c2), "+v"(c3), "=&s"(t0), "=&s"(t1), "=&s"(t2), "=&s"(t3) : "s"(cand), "v"(u[j]), "v"(u[j + 1]), "v"(u[j + 2]), "v"(u[j + 3]));
    }
    const unsigned cl = (c0 + c1) + (c2 + c3);
    int v = (int)cl;
    v += __builtin_amdgcn_update_dpp(0, v, 0xB1, 0xF, 0xF, false);
    v += __builtin_amdgcn_update_dpp(0, v, 0x4E, 0xF, 0xF, false);
    v += __builtin_amdgcn_update_dpp(0, v, 0x141, 0xF, 0xF, false);
    v += __builtin_amdgcn_update_dpp(0, v, 0x140, 0xF, 0xF, false);
    return (__builtin_amdgcn_readlane(v, 0) + __builtin_amdgcn_readlane(v, 16)) + (__builtin_amdgcn_readlane(v, 32) + __builtin_amdgcn_readlane(v, 48));
}
template <int NJ>
__device__ __forceinline__ unsigned select_row(const LAS float* row, int qpos, int lane) {
    unsigned u[NJ];
#pragma unroll
    for (int j = 0; j < NJ; ++j) { const int key = 64 * j + lane; const float v = row[key]; u[j] = (key <= qpos) ? sortable(v) : 0u; }
    unsigned val = 0u;
#define SEL_PUT(j, m) do { const unsigned long long m_ = (m); const unsigned lo_ = (unsigned)m_, hi_ = (unsigned)(m_ >> 32); \
        asm volatile("s_nop 3\n\tv_writelane_b32 %0, %1, %3\n\tv_writelane_b32 %0, %2, %4" : "+v"(val) : "s"(lo_), "s"(hi_), "n"(2 * (j)), "n"(2 * (j) + 1)); } while (0)
    if (qpos < 256) {
#pragma unroll
        for (int j = 0; j < NJ; ++j) SEL_PUT(j, __ballot(u[j] != 0u));
    } else {
        unsigned T = 0u; bool exact = false;
        for (int bit = 31; bit >= 0; --bit) {
            const unsigned cand = T | (1u << bit);
            const int c = count_ge<NJ>(u, cand);
            if (c >= 256) { T = cand; if (c == 256) { exact = true; break; } }
        }
        if (exact) {
#pragma unroll
            for (int j = 0; j < NJ; ++j) SEL_PUT(j, __ballot(u[j] >= T));
        } else {
            int need = 256 - count_ge<NJ>(u, T + 1u);
#pragma unroll
            for (int j = 0; j < NJ; ++j) {
                unsigned long long e = __ballot(u[j] == T);
                const int cnt = __popcll(e);
                if (cnt > need) { unsigned long long t = e; for (int k = 0; k < need; ++k) t &= t - 1; e ^= t; need = 0; }
                else need -= cnt;
                SEL_PUT(j, e | __ballot(u[j] > T));
            }
        }
    }
#undef SEL_PUT
    return val;
}

constexpr int SEL_HB = 16 * SC_PITCH * 4, SEL_HB_STRIDE = 2560;
constexpr int SEL_MM = SEL_HB + 8 * SEL_HB_STRIDE;
#define DPPI(v, ctrl, rmask) __builtin_amdgcn_update_dpp(0, (v), (ctrl), (rmask), 0xF, false)
__device__ __forceinline__ float wave_maxf(float m) {
    m = fmaxf(m, __int_as_float(DPPI(__float_as_int(m), 0xB1, 0xF))); m = fmaxf(m, __int_as_float(DPPI(__float_as_int(m), 0x4E, 0xF)));
    m = fmaxf(m, __int_as_float(DPPI(__float_as_int(m), 0x141, 0xF))); m = fmaxf(m, __int_as_float(DPPI(__float_as_int(m), 0x140, 0xF)));
    const int i = __float_as_int(m);
    return fmaxf(fmaxf(__int_as_float(__builtin_amdgcn_readlane(i, 0)), __int_as_float(__builtin_amdgcn_readlane(i, 16))),
                 fmaxf(__int_as_float(__builtin_amdgcn_readlane(i, 32)), __int_as_float(__builtin_amdgcn_readlane(i, 48))));
}
template <int NJ>
__device__ __forceinline__ unsigned select_fast(const LAS float* row, int qpos, LAS unsigned char* hb, const LAS float* mm, int lane, bool& ok) {
    float v[NJ];
#pragma unroll
    for (int j = 0; j < NJ; ++j) v[j] = row[64 * j + lane];
    const float mx = mm[0], nmn = mm[1];
    const float range = mx + nmn;
    ok = true;
    if (!(range > 1e-20f) || !(range < 1e30f)) { ok = false; return 0u; }
    const float scale = 511.5f * __builtin_amdgcn_rcpf(range), cc = mx * scale;
    *(LAS u32x4*)(hb + lane * 32) = (u32x4){0u, 0u, 0u, 0u}; *(LAS u32x4*)(hb + lane * 32 + 16) = (u32x4){0u, 0u, 0u, 0u};
    if (lane == 0) *(LAS unsigned*)(hb + 2048) = 0u;
    asm volatile("" ::: "memory");
    unsigned sl[NJ]; const unsigned hbase = (unsigned)(size_t)hb;
#pragma unroll
    for (int j = 0; j < NJ; ++j) {
        const float t = __builtin_fmaf(v[j], -scale, cc);
        unsigned s; asm("v_cvt_u32_f32 %0, %1" : "=v"(s) : "v"(t));
        s = min(s, 511u);
        if (j >= NJ - 4) s = ((64 * j + lane) <= qpos) ? s : 512u;
        s = hbase + 4u * s;
        sl[j] = s;
        __hip_atomic_fetch_add((LAS unsigned*)(size_t)s, 1u, __ATOMIC_RELAXED, __HIP_MEMORY_SCOPE_WAVEFRONT);
    }
    asm volatile("" ::: "memory");
    const u32x4 h0 = *(const LAS u32x4*)(hb + lane * 32), h1 = *(const LAS u32x4*)(hb + lane * 32 + 16);
    int q[8]; q[0] = (int)h0[0]; q[1] = q[0] + (int)h0[1]; q[2] = q[1] + (int)h0[2]; q[3] = q[2] + (int)h0[3];
    q[4] = q[3] + (int)h1[0]; q[5] = q[4] + (int)h1[1]; q[6] = q[5] + (int)h1[2]; q[7] = q[6] + (int)h1[3];
    int incl = q[7];
    incl += DPPI(incl, 0x111, 0xF); incl += DPPI(incl, 0x112, 0xF); incl += DPPI(incl, 0x114, 0xF); incl += DPPI(incl, 0x118, 0xF);
    incl += DPPI(incl, 0x142, 0xA); incl += DPPI(incl, 0x143, 0xC);
    const int excl = incl - q[7];
    const int L = __builtin_ctzll(__ballot(incl >= 256));
    int kk = 0, A = excl, B = incl;
#pragma unroll
    for (int k = 0; k < 8; ++k) { const bool lt = (excl + q[k]) < 256; kk += lt ? 1 : 0; A = lt ? excl + q[k] : A; }
#pragma unroll
    for (int k = 6; k >= 0; --k) { const bool lt = (excl + q[k]) < 256; B = lt ? B : excl + q[k]; }
    const int k1 = __builtin_amdgcn_readlane(kk, L), A1 = __builtin_amdgcn_readlane(A, L), B1 = __builtin_amdgcn_readlane(B, L);
    const unsigned p1 = hbase + 4u * (unsigned)(8 * L + k1); const int need = 256 - A1, cnt = B1 - A1;
    if (cnt != need && cnt > 64) { ok = false; return 0u; }
    unsigned val = 0u;
#define SEL_PUT(j, m) do { const unsigned long long m_ = (m); const unsigned lo_ = (unsigned)m_, hi_ = (unsigned)(m_ >> 32); \
        asm volatile("s_nop 1\n\tv_writelane_b32 %0, %1, %3\n\tv_writelane_b32 %0, %2, %4" : "+v"(val) : "s"(lo_), "s"(hi_), "n"(2 * (j)), "n"(2 * (j) + 1)); } while (0)
    if (cnt == need) {
        const unsigned thr = p1 + 4u;
#pragma unroll
        for (int j = 0; j < NJ; ++j) SEL_PUT(j, __ballot(sl[j] < thr));
    } else {
        int base = 0;
#pragma unroll
        for (int j = 0; j < NJ; ++j) {
            const unsigned sj = sl[j];
            SEL_PUT(j, __ballot(sj < p1));
            const bool is = sj == p1; const unsigned long long m = __ballot(is);
            if (m != 0ull) {
                if (is) { const int pos = base + (int)__builtin_amdgcn_mbcnt_hi((unsigned)(m >> 32), __builtin_amdgcn_mbcnt_lo((unsigned)m, 0u));
                    int key = 64 * j + lane; asm volatile("" : "+v"(key));
                    u32x2 e; e.x = (unsigned)(2047 - key); e.y = sortable(row[key]);
                    *(LAS u32x2*)(hb + pos * 8) = e; }
                base += __popcll(m);
            }
        }
        asm volatile("" ::: "memory");
        u32x2 me = (u32x2){0u, 0u};
        if (lane < cnt) me = *(const LAS u32x2*)(hb + lane * 8);
        const unsigned long long cme = ((unsigned long long)me.y << 32) | me.x;
        int rank = 0;
        for (int k = 0; k < cnt; ++k) {
            const unsigned long long ck = ((unsigned long long)(unsigned)__builtin_amdgcn_readlane((int)me.y, k) << 32) | (unsigned)__builtin_amdgcn_readlane((int)me.x, k);
            rank += (ck > cme) ? 1 : 0;
        }
        *(LAS unsigned*)(hb + 1024 + lane * 4) = val;
        asm volatile("" ::: "memory");
        if (lane < cnt && rank < need) { const unsigned key = 2047u - me.x;
            __hip_atomic_fetch_or((LAS unsigned*)(hb + 1024 + (key >> 5) * 4), 1u << (key & 31u), __ATOMIC_RELAXED, __HIP_MEMORY_SCOPE_WAVEFRONT); }
        asm volatile("" ::: "memory");
        val = *(const LAS unsigned*)(hb + 1024 + lane * 4);
    }
#undef SEL_PUT
    return val;
}
struct IdxQ { bf16x8 qf[8][2]; float wh[8]; };
__device__ __forceinline__ void idx_load_q(IdxQ& Q, const Params& P, int b, int qb16, int lane) {
    const bf16_t* IQ = (const bf16_t*)(P.ws + WS_IQ); const float* IW = (const float*)(P.ws + WS_IW);
    const int fr = lane & 15, fq = lane >> 4; const size_t tokq = (size_t)b * SEQ + 16 * qb16 + fr;
#pragma unroll
    for (int h = 0; h < 8; ++h)
#pragma unroll
        for (int ks = 0; ks < 2; ++ks) Q.qf[h][ks] = *(const bf16x8*)(IQ + tokq * 512 + h * 64 + ks * 32 + fq * 8);
    const f32x4 w0 = *(const f32x4*)(IW + tokq * 8), w1 = *(const f32x4*)(IW + tokq * 8 + 4);
#pragma unroll
    for (int e = 0; e < 4; ++e) { Q.wh[e] = w0[e]; Q.wh[4 + e] = w1[e]; }
}
__device__ __forceinline__ void idx_q_finish(IdxQ& Q) {
#pragma unroll
    for (int h = 0; h < 8; ++h) { asm volatile("" : "+v"(Q.qf[h][0]), "+v"(Q.qf[h][1])); asm volatile("" : "+v"(Q.wh[h])); }
}
struct IdxK { bf16x8 ka[4], kb[4]; };
__device__ __forceinline__ void idx_load_k0(IdxK& K, const Params& P, int b, int qb16, int lane, int wave) {
    const bf16_t* IK = (const bf16_t*)(P.ws + WS_IK);
    const int nt = qb16 + 1, fr = lane & 15, fq = lane >> 4; const int nmy = (nt - wave + 7) >> 3;
    const bf16_t* kbase = IK + ((size_t)b * SEQ + wave * 16 + fr) * 64 + fq * 8;
#pragma unroll
    for (int s4 = 0; s4 < 4; ++s4) if (s4 < nmy) { const bf16_t* p_ = kbase + (size_t)s4 * (128 * 64); K.ka[s4] = *(const bf16x8*)p_; K.kb[s4] = *(const bf16x8*)(p_ + 32); }
}
__device__ __forceinline__ void idx_scores(const IdxQ& Q, IdxK& K, const Params& P, int b, int qb16, LAS unsigned char* lds, int lane, int wave) {
    const bf16_t* IK = (const bf16_t*)(P.ws + WS_IK);
    LAS float* sc = (LAS float*)lds;
    const int nt = qb16 + 1, fr = lane & 15, fq = lane >> 4;
    const int nmy = (nt - wave + 7) >> 3;
    const bf16_t* kbase = IK + ((size_t)b * SEQ + wave * 16 + fr) * 64 + fq * 8;
    float tmx = -__builtin_inff(), tnm = -__builtin_inff();
    for (int i0 = 0; i0 < nmy; i0 += 4) {
#pragma unroll
        for (int s4 = 0; s4 < 4; ++s4) {
            const int i = i0 + s4;
            if (i < nmy) {
                const bf16x8 ka = K.ka[s4], kb = K.kb[s4];
                f32x4 s = (f32x4){0.f, 0.f, 0.f, 0.f};
                f32x4 a[8];
#pragma unroll
                for (int h = 0; h < 8; ++h) {
                    a[h] = (f32x4){0.f, 0.f, 0.f, 0.f};
                    a[h] = __builtin_amdgcn_mfma_f32_16x16x32_bf16(ka, Q.qf[h][0], a[h], 0, 0, 0);
                    a[h] = __builtin_amdgcn_mfma_f32_16x16x32_bf16(kb, Q.qf[h][1], a[h], 0, 0, 0);
                }
                if (i + 4 < nmy) { const bf16_t* p_ = kbase + (size_t)(i + 4) * (128 * 64); K.ka[s4] = *(const bf16x8*)p_; K.kb[s4] = *(const bf16x8*)(p_ + 32); }
#pragma unroll
                for (int h = 0; h < 8; ++h)
#pragma unroll
                    for (int e = 0; e < 4; ++e) { const float ae = a[h][e]; s[e] = __builtin_fmaf(Q.wh[h], __int_as_float(max(__float_as_int(ae), 0)), s[e]); }
                *(LAS f32x4*)(sc + fr * SC_PITCH + (wave + 8 * i) * 16 + fq * 4) = s;
                tmx = fmaxf(fmaxf(tmx, s[0]), fmaxf(s[1], fmaxf(s[2], s[3]))); tnm = fmaxf(fmaxf(tnm, -s[0]), fmaxf(-s[1], fmaxf(-s[2], -s[3])));
            }
        }
    }
    if (nmy > 0) { LAS float* mm = (LAS float*)(lds + SEL_MM) + 2 * fr;
        __hip_atomic_fetch_max(mm, tmx, __ATOMIC_RELAXED, __HIP_MEMORY_SCOPE_WORKGROUP); __hip_atomic_fetch_max(mm + 1, tnm, __ATOMIC_RELAXED, __HIP_MEMORY_SCOPE_WORKGROUP); }
}
template <int NJ>
__device__ __forceinline__ unsigned select_any(const LAS float* row, int qpos, LAS unsigned char* hb, const LAS float* mm, int lane) {
    bool ok; const unsigned v = select_fast<NJ>(row, qpos, hb, mm, lane, ok);
    if (ok) return v;
    return select_row<NJ>(row, qpos, lane);
}
__device__ __forceinline__ unsigned idx_select_one(int qpos, const LAS float* row, LAS unsigned char* hb, const LAS float* mm, int lane) {
    const int jn = (qpos >> 6) + 1;
    if (jn <= 4) return select_row<4>(row, qpos, lane);
    else if (jn <= 8) return select_any<8>(row, qpos, hb, mm, lane);
    else if (jn <= 12) return select_any<12>(row, qpos, hb, mm, lane);
    else if (jn <= 16) return select_any<16>(row, qpos, hb, mm, lane);
    else if (jn <= 20) return select_any<20>(row, qpos, hb, mm, lane);
    else if (jn <= 24) return select_any<24>(row, qpos, hb, mm, lane);
    else if (jn <= 28) return select_any<28>(row, qpos, hb, mm, lane);
    else return select_any<32>(row, qpos, hb, mm, lane);
}
__device__ __forceinline__ void idx_select(const Params& P, int b, int qb16, LAS unsigned char* lds, int lane, int wave, IdxQ& Q, IdxK& K, bool has_next) {
    unsigned* SEL = (unsigned*)(P.ws + WS_SEL); LAS float* sc = (LAS float*)lds; const int q0 = 16 * qb16;
    const int ql0 = 2 * wave, qpos0 = q0 + ql0;
    LAS unsigned char* hb = lds + SEL_HB + wave * SEL_HB_STRIDE;
    const unsigned v0 = idx_select_one(qpos0, sc + ql0 * SC_PITCH, hb, (const LAS float*)(lds + SEL_MM) + 2 * ql0, lane);
    if (has_next) { idx_q_finish(Q);
#pragma unroll
        for (int s4 = 0; s4 < 4; ++s4) asm volatile("" : "+v"(K.ka[s4]), "+v"(K.kb[s4])); }
    SEL[((size_t)b * SEQ + qpos0) * 64 + lane] = v0;
    const unsigned v1 = idx_select_one(qpos0 + 1, sc + (ql0 + 1) * SC_PITCH, hb, (const LAS float*)(lds + SEL_MM) + 2 * ql0 + 2, lane);
    SEL[((size_t)b * SEQ + qpos0 + 1) * 64 + lane] = v1;
}
__device__ __forceinline__ void idx_phase(const Params& P, int vcu, int G, LAS unsigned char* lds, int lane, int wave) {
    const int npair = (BATCH * 64 - vcu + G - 1) / G; const int nunit = 2 * npair;
    if (nunit <= 0) return;
    IdxQ Q; IdxK K;
    { const int pi = vcu; idx_load_q(Q, P, pi >> 6, pi & 63, lane); idx_load_k0(K, P, pi >> 6, pi & 63, lane, wave); idx_q_finish(Q); }
    if (lane < 4) ((LAS float*)(lds + SEL_MM))[4 * wave + lane] = -__builtin_inff();
    __syncthreads();
#pragma unroll 1
    for (int un = 0; un < nunit; ++un) {
        const int pi = vcu + (un >> 1) * G; const int b = pi >> 6, qb = (un & 1) ? 127 - (pi & 63) : (pi & 63);
        idx_scores(Q, K, P, b, qb, lds, lane, wave);
        if (DBL_MASK & 128) { __syncthreads(); idx_load_k0(K, P, b, qb, lane, wave); idx_scores(Q, K, P, b, qb, lds, lane, wave); }
        __syncthreads();
        if (un + 1 < nunit) { const int pn = vcu + ((un + 1) >> 1) * G; const int bn = pn >> 6, qn = ((un + 1) & 1) ? 127 - (pn & 63) : (pn & 63);
            idx_load_q(Q, P, bn, qn, lane); idx_load_k0(K, P, bn, qn, lane, wave); }
        idx_select(P, b, qb, lds, lane, wave, Q, K, un + 1 < nunit);
        if (DBL_MASK & 256) idx_select(P, b, qb, lds, lane, wave, Q, K, false);
        asm volatile("" ::: "memory");
        if (lane < 4) ((LAS float*)(lds + SEL_MM))[4 * wave + lane] = -__builtin_inff();
        __syncthreads();
    }
}

constexpr int ASLOT = 32768, AV_OFF = 16384;
__device__ __forceinline__ int crow(int r, int hi) { return (r & 3) + 8 * (r >> 2) + 4 * hi; }
__device__ __forceinline__ s16x4 vtr(const LAS unsigned char* p) { typedef short v4i16_t __attribute__((ext_vector_type(4))); return __builtin_bit_cast(s16x4, __builtin_amdgcn_ds_read_tr16_b64_v4i16((LAS v4i16_t*)p)); }
struct AttnNext { const bf16_t* Kg; const bf16_t* Vg; const bf16_t* Qg; bool has; };

__device__ __forceinline__ void glds16(const void* gsrc, unsigned lds_dst) { unsigned keep;
    asm volatile("s_mov_b32 %0, m0\n\ts_mov_b32 m0, %2\n\ts_nop 0\n\tglobal_load_lds_dwordx4 %1, off\n\ts_mov_b32 m0, %0" : "=&s"(keep) : "v"(gsrc), "s"(lds_dst) : "memory"); }
#define LDSADDR(p) ((unsigned)__builtin_amdgcn_readfirstlane((int)(unsigned)(size_t)(p)))
template <int KD>
__device__ __forceinline__ void attn_dma(const bf16_t* Kg, const bf16_t* Vg, int t, LAS unsigned char* slot, int wid, int lane) {
    if (KD == 128) {
#pragma unroll
        for (int i = 0; i < 2; ++i) { const int P = wid + 8 * i, row = 4 * P + (lane >> 4), c = (lane & 15) ^ (row & 15);
            glds16(Kg + (size_t)(64 * t + row) * 512 + c * 8, LDSADDR(slot + P * 1024)); }
    } else {
        const int P = wid, row = 8 * P + (lane >> 3), c = (lane & 7) ^ ((row >> 1) & 7);
        glds16(Kg + (size_t)(64 * t + row) * 512 + c * 8, LDSADDR(slot + P * 1024));
    }
#pragma unroll
    for (int i = 0; i < 2; ++i) { const int P = wid + 8 * i, row = 4 * P + (lane >> 4), pc = lane & 15, c = (((pc >> 2) ^ (row & 3)) << 2) | (pc & 3);
        glds16(Vg + (size_t)(64 * t + row) * 512 + c * 8, LDSADDR(slot + ((KD == 128) ? 16384 : 8192) + P * 1024)); }
}

template <int KD, bool TM>
__device__ __forceinline__ void attn_pass(f32x16 (&o)[4], float& lsum, bf16x8 (&qf)[KD / 16], const bf16_t* Kg, const bf16_t* Vg, const unsigned* SELq  ,
                                          int q0, int wid, int lane, LAS unsigned char* lds, int (&ring)[3], const AttnNext& nx) {
    constexpr int NKS = KD / 16, KROW = KD * 2, NDMA = (KD == 128) ? 4 : 3;
    const int r32 = lane & 31, hi = lane >> 5;
#pragma unroll
    for (int d = 0; d < 4; ++d)
#pragma unroll
        for (int r = 0; r < 16; ++r) o[d][r] = 0.f;
    constexpr bool NEGM = !TM;
    float mrun = NEGM ? 0.f : -1e30f, l = 0.f;
    f32x16 negm;
#pragma unroll
    for (int r = 0; r < 16; ++r) negm[r] = 0.f;
    const int NT = (q0 + 256) / 64, tlast = q0 / 64 + (wid >> 1);
    const int kswz = (KD == 128) ? (r32 & 15) : ((r32 >> 1) & 7);
    const int kbase = r32 * KROW + ((hi ^ kswz) << 4);
    const int vq = (lane & 15) >> 2;
    const int vbase = (4 * hi + vq) * 256 + (vq << 6) + 32 * ((lane >> 4) & 1) + 8 * (lane & 3);
    u32x2 selw_next = (u32x2){0u, 0u};
    if (TM) selw_next = *(const u32x2*)(SELq);
    for (int t = 0; t < NT; ++t) {
        LAS unsigned char* cur = lds + ring[0]; LAS unsigned char* dst = lds + ring[2];
        const u32x2 selw = selw_next;
        const bool act = t <= tlast;
        f32x16 p[2];
        if (act) {
            const LAS unsigned char* kb = cur;
#pragma unroll
            for (int u = 0; u < 2; ++u) {
                bf16x8 kf[NKS];
#pragma unroll
                for (int ks = 0; ks < NKS; ++ks) kf[ks] = *(const LAS bf16x8*)(kb + u * 32 * KROW + (kbase ^ (ks << 5)));
                if (NEGM) p[u] = negm;
                else {
#pragma unroll
                    for (int r = 0; r < 16; ++r) p[u][r] = 0.f;
                }
#pragma unroll
                for (int ks = 0; ks < NKS; ++ks) p[u] = __builtin_amdgcn_mfma_f32_32x32x16_bf16(kf[ks], qf[ks], p[u], 0, 0, 0);
            }
            if (TM) {
#pragma unroll
                for (int u = 0; u < 2; ++u) { const unsigned w = selw[u] >> (4 * hi);
#pragma unroll
                    for (int r = 0; r < 16; ++r) { const unsigned m = (unsigned)__builtin_amdgcn_sbfe((int)w, (r & 3) + 8 * (r >> 2), 1);
                        const float x = p[u][r]; const unsigned xb = __float_as_uint(x); p[u][r] = __uint_as_float((m & xb) | (~m & 0xff800000u)); } }
            } else if (t == tlast) {
                const int qrel = 32 * (wid & 1) + r32;
#pragma unroll
                for (int u = 0; u < 2; ++u)
#pragma unroll
                    for (int r = 0; r < 16; ++r) { if (32 * u + crow(r, hi) > qrel) p[u][r] = -INFINITY; }
            }
        }
        bool issued = true;
        if (TM && t + 1 < NT) selw_next = *(const u32x2*)(SELq + 2 * (t + 1));
        if (t + 2 < NT) attn_dma<KD>(Kg, Vg, t + 2, dst, wid, lane);
        else if (nx.has) attn_dma<KD>(nx.Kg, nx.Vg, t + 2 - NT, dst, wid, lane);
        else issued = false;
        if (act) {
            const LAS unsigned char* vb = cur + ((KD == 128) ? 16384 : 8192);
            float rm;
            { float a = fmaxf(fmaxf(p[0][0], p[0][1]), p[1][0]), b = fmaxf(fmaxf(p[0][2], p[0][3]), p[1][1]); a = fmaxf(fmaxf(a, p[1][2]), p[1][3]);
#pragma unroll
              for (int r = 4; r < 16; r += 4) { a = fmaxf(fmaxf(a, p[0][r]), p[0][r + 1]); b = fmaxf(fmaxf(b, p[0][r + 2]), p[0][r + 3]); a = fmaxf(fmaxf(a, p[1][r]), p[1][r + 1]); b = fmaxf(fmaxf(b, p[1][r + 2]), p[1][r + 3]); }
              rm = fmaxf(a, b); }
            rm = fmaxf(rm, __shfl_xor(rm, 32));
            if (NEGM) {
                if (t == 0 || __any(rm > 8.0f)) {
                    const float dl = (t == 0) ? rm : fmaxf(rm, 0.f), alpha = (t == 0) ? 1.f : __builtin_amdgcn_exp2f(-dl); mrun += dl; l *= alpha;
#pragma unroll
                    for (int u = 0; u < 2; ++u)
#pragma unroll
                        for (int r = 0; r < 16; ++r) p[u][r] -= dl;
#pragma unroll
                    for (int d = 0; d < 4; ++d)
#pragma unroll
                        for (int r = 0; r < 16; ++r) o[d][r] *= alpha;
#pragma unroll
                    for (int r = 0; r < 16; ++r) negm[r] = -mrun;
                }
            } else if (__any(rm > mrun + 8.0f)) {
                const float mn = fmaxf(mrun, rm), alpha = __builtin_amdgcn_exp2f(mrun - mn); mrun = mn; l *= alpha;
#pragma unroll
                for (int d = 0; d < 4; ++d)
#pragma unroll
                    for (int r = 0; r < 16; ++r) o[d][r] *= alpha;
            }
            float ps = 0.f;
#pragma unroll
            for (int u = 0; u < 2; ++u)
#pragma unroll
                for (int r = 0; r < 16; ++r) { p[u][r] = __builtin_amdgcn_exp2f(NEGM ? p[u][r] : p[u][r] - mrun); ps += p[u][r]; }
            l += ps;
#pragma unroll
            for (int u = 0; u < 2; ++u)
#pragma unroll
                for (int s = 0; s < 2; ++s) {
                    u32x4 pw; pw.x = pk2(p[u][8 * s], p[u][8 * s + 1]); pw.y = pk2(p[u][8 * s + 2], p[u][8 * s + 3]); pw.z = pk2(p[u][8 * s + 4], p[u][8 * s + 5]); pw.w = pk2(p[u][8 * s + 6], p[u][8 * s + 7]);
                    const bf16x8 pf = __builtin_bit_cast(bf16x8, pw);
                    const LAS unsigned char* vp = vb + (32 * u + 16 * s) * 256;
                    s16x4 lo[4], hh[4];
#pragma unroll
                    for (int d = 0; d < 4; ++d) { lo[d] = vtr(vp + (vbase ^ (d << 6))); hh[d] = vtr(vp + (vbase ^ (d << 6)) + 8 * 256); }
#pragma unroll
                    for (int d = 0; d < 4; ++d) {
                        const bf16x8 vf = (bf16x8){lo[d][0], lo[d][1], lo[d][2], lo[d][3], hh[d][0], hh[d][1], hh[d][2], hh[d][3]};
                        o[d] = __builtin_amdgcn_mfma_f32_32x32x16_bf16(vf, pf, o[d], 0, 0, 0);
                    }
                }
        }
        if (issued) asm volatile("s_waitcnt vmcnt(%0) lgkmcnt(0)" :: "n"(NDMA) : "memory");
        else asm volatile("s_waitcnt vmcnt(0) lgkmcnt(0)" ::: "memory");
        __builtin_amdgcn_s_barrier();
        asm volatile("" ::: "memory");
        { const int r0 = ring[0]; ring[0] = ring[1]; ring[1] = ring[2]; ring[2] = r0; }
    }
    if (nx.has) {
#pragma unroll
        for (int ks = 0; ks < NKS; ++ks) qf[ks] = *(const bf16x8*)(nx.Qg + (size_t)r32 * 1024 + 16 * ks + 8 * hi);
    }
    lsum = l + __shfl_xor(l, 32);
}
template <int NKS>
__device__ __forceinline__ void attn_load_q(bf16x8 (&qf)[NKS], const bf16_t* Qg, int lane) {
#pragma unroll
    for (int ks = 0; ks < NKS; ++ks) qf[ks] = *(const bf16x8*)(Qg + (size_t)(lane & 31) * 1024 + 16 * ks + 8 * (lane >> 5));
}

__device__ __forceinline__ void attn_store_rows(const f32x16 (&o)[4], float rowscale, LAS unsigned char* stg, const bf16_t* gate0  ,
                                                bf16_t* out0  , const float* sw, int lane) {
    const int r32 = lane & 31, hi = lane >> 5;
    const unsigned gl = (unsigned)((lane >> 3) * 512 + 8 * (lane & 7)) * 2u, ol = (unsigned)((lane >> 3) * 1024 + 8 * (lane & 7)) * 2u;
    const int wl = r32 * 128 + 8 * hi, rl = (lane >> 3) * 128;
#pragma unroll
    for (int hf = 0; hf < 2; ++hf) {
        u32x4 gv[4];
#pragma unroll
        for (int i = 0; i < 4; ++i) gv[i] = *(const u32x4*)((const unsigned char*)gate0 + (i * 8 * 512 + 64 * hf) * 2 + gl);
#pragma unroll
        for (int dd = 0; dd < 2; ++dd)
#pragma unroll
            for (int g = 0; g < 4; ++g) { const int d = 2 * hf + dd; u32x2 w; w.x = pk2(o[d][4 * g] * rowscale, o[d][4 * g + 1] * rowscale); w.y = pk2(o[d][4 * g + 2] * rowscale, o[d][4 * g + 3] * rowscale);
                *(LAS u32x2*)(stg + wl + (((dd * 4 + g) ^ (r32 & 7)) << 4)) = w; }
        asm volatile("s_waitcnt lgkmcnt(0)" ::: "memory");
        f32x4 w0 = (f32x4){1.f, 1.f, 1.f, 1.f}, w1 = w0;
        if (sw) { w0 = *(const f32x4*)(sw + 64 * hf + 8 * (lane & 7)); w1 = *(const f32x4*)(sw + 64 * hf + 8 * (lane & 7) + 4); }
#pragma unroll
        for (int i = 0; i < 4; ++i) { const int rsw = ((lane >> 3) & 7);
            const u32x4 v = *(const LAS u32x4*)(stg + i * 1024 + rl + (((lane & 7) ^ rsw) << 4));
            const u32x4 g4 = gv[i]; u32x4 r;
            r.x = pk2(bflo(v.x) * w0[0] * bflo(g4.x), bfhi(v.x) * w0[1] * bfhi(g4.x)); r.y = pk2(bflo(v.y) * w0[2] * bflo(g4.y), bfhi(v.y) * w0[3] * bfhi(g4.y));
            r.z = pk2(bflo(v.z) * w1[0] * bflo(g4.z), bfhi(v.z) * w1[1] * bfhi(g4.z)); r.w = pk2(bflo(v.w) * w1[2] * bflo(g4.w), bfhi(v.w) * w1[3] * bfhi(g4.w));
            *(u32x4*)((unsigned char*)out0 + (i * 8 * 1024 + 64 * hf) * 2 + ol) = r; }
        asm volatile("s_waitcnt lgkmcnt(0)" ::: "memory");
    }
}

struct AttnUnit { int b, h, qblk; };
__device__ __forceinline__ AttnUnit attn_unit_of(int vcu, int G, int un) { const int pi = vcu + (un >> 1) * G; AttnUnit u; u.b = pi >> 4; u.h = (pi >> 2) & 3; u.qblk = (un & 1) ? (pi & 3) : 7 - (pi & 3); return u; }
__device__ __forceinline__ void diff_phase(const Params& P, int layer, int vcu, int G, LAS unsigned char* lds, int lane, int wid, bool dummy) {
    bf16_t* QMIX = (bf16_t*)(P.ws + WS_QMIX); const bf16_t* DK = (const bf16_t*)(P.ws + WS_DK); const bf16_t* DV = (const bf16_t*)(P.ws + WS_DV); const bf16_t* DG = (const bf16_t*)(P.ws + WS_DG);
    const float* lamp = (const float*)(P.ws + WS_TAB + TB_LAM);
    const int nunit = 2 * ((BATCH * 16 - vcu + G - 1) / G);
    if (nunit <= 0) return;
    const int r32 = lane & 31, hi = lane >> 5;
    int ring[3] = {0, 24576, 49152}; bf16x8 qf[4];
    { const AttnUnit u0 = attn_unit_of(vcu, G, 0); const size_t tok0 = (size_t)u0.b * SEQ + 256 * u0.qblk + 32 * wid;
      attn_dma<64>(DK + (size_t)u0.b * SEQ * 512 + u0.h * 128, DV + (size_t)u0.b * SEQ * 512 + u0.h * 128, 0, lds + ring[0], wid, lane);
      attn_dma<64>(DK + (size_t)u0.b * SEQ * 512 + u0.h * 128, DV + (size_t)u0.b * SEQ * 512 + u0.h * 128, 1, lds + ring[1], wid, lane);
      attn_load_q<4>(qf, QMIX + tok0 * 1024 + u0.h * 128, lane);
      asm volatile("s_waitcnt vmcnt(0)" ::: "memory"); __builtin_amdgcn_s_barrier(); asm volatile("" ::: "memory"); }
#pragma unroll 1
    for (int un = 0; un < nunit; ++un) {
        const AttnUnit u = attn_unit_of(vcu, G, un);
        const int q0 = 256 * u.qblk; const size_t tok0 = (size_t)u.b * SEQ + q0 + 32 * wid;
        const bf16_t* Kg = DK + (size_t)u.b * SEQ * 512 + u.h * 128; const bf16_t* Vg = DV + (size_t)u.b * SEQ * 512 + u.h * 128;
        float l1;
        LAS unsigned* park = (LAS unsigned*)(lds + 77824 + wid * 8192) + lane;
        f32x16 o1[4];
        { float l0; AttnNext nx{Kg + 64, Vg, QMIX + tok0 * 1024 + u.h * 128 + 64, true};
          attn_pass<64, false>(o1, l0, qf, Kg, Vg, nullptr, q0, wid, lane, lds, ring, nx);
          const float il = 1.f / l0;
#pragma unroll
          for (int d = 0; d < 4; ++d)
#pragma unroll
              for (int i = 0; i < 8; ++i) park[(d * 8 + i) * 64] = pk2(o1[d][2 * i] * il, o1[d][2 * i + 1] * il); }
        { AttnNext nx{nullptr, nullptr, nullptr, false};
          if (un + 1 < nunit) { const AttnUnit v = attn_unit_of(vcu, G, un + 1); nx.Kg = DK + (size_t)v.b * SEQ * 512 + v.h * 128; nx.Vg = DV + (size_t)v.b * SEQ * 512 + v.h * 128;
              nx.Qg = QMIX + ((size_t)v.b * SEQ + 256 * v.qblk + 32 * wid) * 1024 + v.h * 128; nx.has = true; }
          attn_pass<64, false>(o1, l1, qf, Kg + 64, Vg, nullptr, q0, wid, lane, lds, ring, nx); }
        const float lam = lamp[2 * layer], li = lamp[2 * layer + 1];
        { const float f = lam / l1; float ss = 0.f;
#pragma unroll
          for (int d = 0; d < 4; ++d)
#pragma unroll
              for (int i = 0; i < 8; ++i) { const unsigned pw_ = park[(d * 8 + i) * 64]; o1[d][2 * i] = bflo(pw_) - f * o1[d][2 * i]; o1[d][2 * i + 1] = bfhi(pw_) - f * o1[d][2 * i + 1]; ss += o1[d][2 * i] * o1[d][2 * i] + o1[d][2 * i + 1] * o1[d][2 * i + 1]; }
          ss += __shfl_xor(ss, 32);
          const float rs = rsqrtf(ss * (1.f / 128.f) + 1e-5f) * (1.f - li);
          attn_store_rows(o1, rs, lds + 77824 + wid * 8192, DG + tok0 * 512 + u.h * 128, (bf16_t*)(P.ws + (dummy ? WS_DUMMY : WS_QMIX)) + tok0 * 1024 + u.h * 128, P.subln_w + layer * 128, lane); }
    }
}

__device__ __forceinline__ void dsa_phase(const Params& P, int vcu, int G, LAS unsigned char* lds, int lane, int wid, bool dummy) {
    bf16_t* QMIX = (bf16_t*)(P.ws + WS_QMIX); const bf16_t* SK = (const bf16_t*)(P.ws + WS_SK); const bf16_t* SV = (const bf16_t*)(P.ws + WS_SV); const bf16_t* SG = (const bf16_t*)(P.ws + WS_SG);
    const unsigned* SEL = (const unsigned*)(P.ws + WS_SEL);
    const int nunit = 2 * ((BATCH * 16 - vcu + G - 1) / G);
    if (nunit <= 0) return;
    const int r32 = lane & 31, hi = lane >> 5;
    int ring[3] = {0, 32768, 65536}; bf16x8 qf[8];
    { const AttnUnit u0 = attn_unit_of(vcu, G, 0); const size_t tok0 = (size_t)u0.b * SEQ + 256 * u0.qblk + 32 * wid;
      attn_dma<128>(SK + (size_t)u0.b * SEQ * 512 + u0.h * 128, SV + (size_t)u0.b * SEQ * 512 + u0.h * 128, 0, lds + ring[0], wid, lane);
      attn_dma<128>(SK + (size_t)u0.b * SEQ * 512 + u0.h * 128, SV + (size_t)u0.b * SEQ * 512 + u0.h * 128, 1, lds + ring[1], wid, lane);
      attn_load_q<8>(qf, QMIX + tok0 * 1024 + 512 + u0.h * 128, lane);
      asm volatile("s_waitcnt vmcnt(0)" ::: "memory"); __builtin_amdgcn_s_barrier(); asm volatile("" ::: "memory"); }
#pragma unroll 1
    for (int un = 0; un < nunit; ++un) {
        const AttnUnit u = attn_unit_of(vcu, G, un);
        const int q0 = 256 * u.qblk; const size_t tok0 = (size_t)u.b * SEQ + q0 + 32 * wid;
        const bf16_t* Kg = SK + (size_t)u.b * SEQ * 512 + u.h * 128; const bf16_t* Vg = SV + (size_t)u.b * SEQ * 512 + u.h * 128;
        AttnNext nx{nullptr, nullptr, nullptr, false};
        if (un + 1 < nunit) { const AttnUnit v = attn_unit_of(vcu, G, un + 1); nx.Kg = SK + (size_t)v.b * SEQ * 512 + v.h * 128; nx.Vg = SV + (size_t)v.b * SEQ * 512 + v.h * 128;
            nx.Qg = QMIX + ((size_t)v.b * SEQ + 256 * v.qblk + 32 * wid) * 1024 + 512 + v.h * 128; nx.has = true; }
        f32x16 o[4]; float l;
        attn_pass<128, true>(o, l, qf, Kg, Vg, SEL + (tok0 + r32) * 64, q0, wid, lane, lds, ring, nx);
        attn_store_rows(o, 1.f / l, lds + 98304 + wid * 4096, SG + tok0 * 512 + u.h * 128, (bf16_t*)(P.ws + (dummy ? WS_DUMMY : WS_QMIX)) + tok0 * 1024 + 512 + u.h * 128, nullptr, lane);
    }
}

#define XB_TMO      128
#define XB_XCNT(j)  (256  + 64 * (j))
#define XB_XSUB(j)  (1280 + 64 * (j))
#define XB_XGEN(j)  (2304 + 64 * (j))
#define XB_TOP      3328
#define XB_TOPGEN   3392
#define XCD_BAR_WORDS 3456
#define XB_SPIN_CAP (1u << 18)
__device__ __forceinline__ unsigned xb_ld(unsigned* p)              { return __hip_atomic_load(p, __ATOMIC_RELAXED, __HIP_MEMORY_SCOPE_AGENT); }
__device__ __forceinline__ unsigned xb_add(unsigned* p, unsigned v) { return __hip_atomic_fetch_add(p, v, __ATOMIC_RELAXED, __HIP_MEMORY_SCOPE_AGENT); }
__device__ __forceinline__ unsigned xb_xcc_id() { return (unsigned)__builtin_amdgcn_s_getreg((3 << 11) | 20) & 0xFu; }
#define XB_SPIN(cond, bar) do { unsigned _sp = 0; while (cond) { __builtin_amdgcn_s_sleep(1); \
    if ((++_sp & 255u) == 0u) { if (xb_ld(&(bar)[XB_TMO])) break; if (_sp > XB_SPIN_CAP) { atomicAdd(&(bar)[XB_TMO], 1u); break; } } } } while (0)
struct XcdBarrier { unsigned* bar; unsigned x; volatile LAS unsigned* st; };
__device__ __forceinline__ XcdBarrier xcd_barrier_post(unsigned* bar, volatile LAS unsigned* st) {
    XcdBarrier b; b.bar = bar; b.x = xb_xcc_id(); b.st = st;
    if (threadIdx.x == 0) (void)xb_add(&bar[XB_XCNT(b.x)], 1u);
    return b;
}
__device__ __forceinline__ void xcd_barrier_complete(unsigned* bar, unsigned x, unsigned& nloc, unsigned& nx) {
    const unsigned G = gridDim.x * gridDim.y * gridDim.z;
    unsigned sum, cnt, mine, sp = 0u;
    for (;;) {
        sum = 0u; cnt = 0u; mine = 0u;
#pragma unroll
        for (unsigned j = 0; j < 16; ++j) { const unsigned c = xb_ld(&bar[XB_XCNT(j)]); sum += c; cnt += (c > 0u) ? 1u : 0u; mine = (j == x) ? c : mine; }
        if (sum == G) break;
        __builtin_amdgcn_s_sleep(1);
        if ((++sp & 255u) == 0u) { if (xb_ld(&bar[XB_TMO])) break; if (sp > XB_SPIN_CAP) { atomicAdd(&bar[XB_TMO], 1u); break; } }
    }
    nloc = mine > 0u ? mine : 1u; nx = cnt > 0u ? cnt : 1u;
}
__device__ __forceinline__ void xcd_barrier(const XcdBarrier& b) {
    asm volatile("s_waitcnt vmcnt(0)" ::: "memory");
    __syncthreads();
    if (threadIdx.x == 0) {
        unsigned* bar = b.bar;
        __builtin_amdgcn_s_waitcnt(0);
        const unsigned bx_ = xb_xcc_id();
        unsigned nloc = b.st[0], nx = b.st[1];
        if (nloc == 0u) { xcd_barrier_complete(bar, bx_, nloc, nx); b.st[0] = nloc; b.st[1] = nx; }
        const unsigned old = xb_add(&bar[XB_XSUB(bx_)], 1u);
        const unsigned gen = old / nloc;
        if (old + 1u == (gen + 1u) * nloc) {
            __builtin_amdgcn_fence(__ATOMIC_RELEASE, "agent");
            asm volatile("s_waitcnt vmcnt(0)" ::: "memory");
            const unsigned og = xb_add(&bar[XB_TOP], 1u);
            const unsigned tg = og / nx;
            if (og + 1u == (tg + 1u) * nx) xb_add(&bar[XB_TOPGEN], 1u);
            else XB_SPIN(xb_ld(&bar[XB_TOPGEN]) == tg, bar);
            __builtin_amdgcn_fence(__ATOMIC_ACQUIRE, "agent");
            xb_add(&bar[XB_XGEN(bx_)], 1u);
            asm volatile("s_waitcnt vmcnt(0)" ::: "memory");
        } else {
            XB_SPIN(xb_ld(&bar[XB_XGEN(bx_)]) == gen, bar);
            __builtin_amdgcn_fence(__ATOMIC_ACQUIRE, "agent");
            asm volatile("s_waitcnt vmcnt(0)" ::: "memory");
        }
    }
    __syncthreads();
}

__global__ void __launch_bounds__(512, 2) hybrid_fwd(Params P) {
    extern __shared__ __attribute__((aligned(16))) unsigned char lds_raw[];
    LAS unsigned char* lds = (LAS unsigned char*)lds_raw;
    volatile LAS unsigned* bst = (volatile LAS unsigned*)(lds + LDS_BYTES - 64);
    if (threadIdx.x < 16) bst[threadIdx.x] = 0u;
    __syncthreads();
    const XcdBarrier gbar = xcd_barrier_post((unsigned*)(P.ws + WS_CTL) + 4096, bst);
#define GRID_SYNC() xcd_barrier(gbar)
    int tid = threadIdx.x, lane = tid & 63; const int wave = __builtin_amdgcn_readfirstlane(tid >> 6);
#define FRESH_TID() do { tid = threadIdx.x; asm volatile("" : "+v"(tid)); lane = tid & 63; } while (0)
    const int G = gridDim.x; const int bx = blockIdx.x; const int vcu = (G % 8 == 0) ? (bx % 8) * (G / 8) + bx / 8 : bx;

    if (PH_MASK & 1) prep_phase(P, lds, tid, lane, wave);
    GRID_SYNC();
    for (int layer = 0; layer < DEPTH; ++layer) {
        FRESH_TID();
        FRESH_TID();
        if (PH_MASK & 4) {
            pg8::Gemm g{(const bf16_t*)(P.ws + WS_XB), (const bf16_t*)(P.ws + WS_WIN) + (size_t)layer * NPAD * DM, MTOK, NPAD, DM};
            pg8::StaticOrder S; S.init(MTOK, NPAD, G, bx);
            EpiInProj E{P.ws, P.iknw + layer * 64, P.iknb + layer * 64};
            pg8::gemm_phase<EpiInProj, pg8::StaticOrder, true, true>(lds, g, S, E, tid);
            if (layer == 0) {
                const int nfull = (MTOK / 256) * (NPAD / 256) - 9 * G;
                if (bx >= nfull && nfull >= 0 && nfull < G) convert_weights(P, (LAS float*)(lds + wave * 16384), 1, DEPTH, (bx - nfull) * 8 + wave, (G - nfull) * 8, lane);
                else if (nfull < 0 || nfull >= G) convert_weights(P, (LAS float*)(lds + wave * 16384), 1, DEPTH, bx * 8 + wave, G * 8, lane);
            }
            if (DBL_MASK & 4) { __syncthreads(); pg8::gemm_phase<EpiInProj, pg8::StaticOrder, true, true>(lds, g, S, E, tid); }
        }
        GRID_SYNC();
        {
            FRESH_TID();
            for (int rep = 0; rep < ((DBL_MASK & 8) ? 2 : 1); ++rep)
            if (PH_MASK & 8) idx_phase(P, vcu, G, lds, lane, wave);
            FRESH_TID();
            for (int rep = (DBL_MASK & 16) ? 0 : 1; rep < 2; ++rep)
            if (PH_MASK & 16) { if (wave >= 4) __builtin_amdgcn_s_setprio(1); diff_phase(P, layer, vcu, G, lds, lane, wave, rep == 0); if (wave >= 4) __builtin_amdgcn_s_setprio(0); }
        }
        GRID_SYNC();
        {
            FRESH_TID();
            for (int rep = (DBL_MASK & 32) ? 0 : 1; rep < 2; ++rep)
            if (PH_MASK & 32) { if (wave >= 4) __builtin_amdgcn_s_setprio(1); dsa_phase(P, vcu, G, lds, lane, wave, rep == 0); if (wave >= 4) __builtin_amdgcn_s_setprio(0); }
        }
        GRID_SYNC();
        FRESH_TID();
        if (PH_MASK & 64) {
            pg8::Gemm g{(const bf16_t*)(P.ws + WS_QMIX), (const bf16_t*)(P.ws + WS_WOUT) + (size_t)layer * DM * DM, MTOK, DM, DM};
            pg8::StaticOrder S; S.init(MTOK, DM, G, bx);
            EpiOutNorm E{P.ws, P.post_w + layer * DM, P.out, layer, layer == DEPTH - 1};
            pg8::gemm_phase<EpiOutNorm, pg8::StaticOrder, true, true>(lds, g, S, E, tid);
        }
        if (layer + 1 < DEPTH) GRID_SYNC();
    }
}

extern "C" void kernel_launch(void* const* d_in, const int* in_sizes, int n_in, void* d_out, int out_size, void* d_ws, size_t ws_size, hipStream_t stream) {
    static int grid_blocks = 0;
    if (grid_blocks == 0) {
        if (n_in != 13 || in_sizes[0] != MTOK * DM || out_size != MTOK * DM || ws_size < WS_END) {
            fprintf(stderr, "kernel_launch: unexpected shapes (n_in %d, in0 %d, out %d, ws %zu); nothing launched\n", n_in, n_in > 0 ? in_sizes[0] : -1, out_size, ws_size); grid_blocks = -1; return; }
        int dev = 0, cus = 0, per_cu = 0;
        hipGetDevice(&dev); hipDeviceGetAttribute(&cus, hipDeviceAttributeMultiprocessorCount, dev);
        hipFuncSetAttribute((const void*)hybrid_fwd, hipFuncAttributeMaxDynamicSharedMemorySize, LDS_BYTES);
        hipOccupancyMaxActiveBlocksPerMultiprocessor(&per_cu, (const void*)hybrid_fwd, 512, LDS_BYTES);
        if (per_cu < 1) { fprintf(stderr, "kernel_launch: occupancy query says %d blocks per CU\n", per_cu); per_cu = 1; }
        grid_blocks = cus;
        (void)hipGetLastError();
    }
    if (grid_blocks < 0) return;
    if (hipMemsetAsync((char*)d_ws + WS_CTL, 0, 524288, stream) != hipSuccess) { fprintf(stderr, "kernel_launch: memset failed\n"); return; }
    Params p{};
    p.x = (const float*)d_in[0]; p.positions = (const int*)d_in[1]; p.pre_w = (const float*)d_in[2]; p.post_w = (const float*)d_in[3]; p.w_in = (const float*)d_in[4]; p.w_out = (const float*)d_in[5];
    p.lq1 = (const float*)d_in[6]; p.lk1 = (const float*)d_in[7]; p.lq2 = (const float*)d_in[8]; p.lk2 = (const float*)d_in[9]; p.subln_w = (const float*)d_in[10]; p.iknw = (const float*)d_in[11]; p.iknb = (const float*)d_in[12];
    p.out = (float*)d_out; p.ws = (unsigned char*)d_ws;
    void* args[] = {&p};
    hipError_t e = hipLaunchCooperativeKernel((const void*)hybrid_fwd, dim3(grid_blocks), dim3(512), args, LDS_BYTES, stream);
    if (e != hipSuccess) fprintf(stderr, "cooperative launch failed: %s (grid %d)\n", hipGetErrorString(e), grid_blocks);
}
```

```cpp
#include <hip/hip_runtime.h>
#ifndef PH_MASK
#define PH_MASK 127
#endif
#ifndef DBL_MASK
#define DBL_MASK 0
#endif
#include <cstdio>
#include <cstdint>

#define LAS __attribute__((address_space(3)))
typedef unsigned short bf16_t;
typedef short bf16x8 __attribute__((ext_vector_type(8)));
typedef short s16x4 __attribute__((ext_vector_type(4)));
typedef float f32x4 __attribute__((ext_vector_type(4)));
typedef float f32x16 __attribute__((ext_vector_type(16)));
typedef unsigned u32x4 __attribute__((ext_vector_type(4)));
typedef unsigned u32x2 __attribute__((ext_vector_type(2)));

constexpr int BATCH = 16, SEQ = 2048, DM = 1024, DEPTH = 4, NIN = 4680, NPAD = 4864, MTOK = BATCH * SEQ;
constexpr float LOG2E = 1.4426950408889634f;
constexpr size_t MiB = 1u << 20;
constexpr size_t WS_CTL = 0, WS_WIN = 1 * MiB, WS_WOUT = 39 * MiB, WS_TAB = 47 * MiB, WS_XB = 48 * MiB, WS_QMIX = 112 * MiB,
                 WS_DK = 176 * MiB, WS_DV = 208 * MiB, WS_Y = 176 * MiB  , WS_DG = 240 * MiB, WS_SK = 272 * MiB, WS_SV = 304 * MiB,
                 WS_SG = 336 * MiB, WS_IQ = 368 * MiB, WS_IK = 400 * MiB, WS_IW = 404 * MiB, WS_SEL = 405 * MiB, WS_END = 418 * MiB, WS_DUMMY = 420 * MiB  ;
constexpr size_t TB_CS64 = 0, TB_SN64 = 65536, TB_CS128 = 131072, TB_SN128 = 262144, TB_LAM = 393216, TB_RSTD = 397312;
constexpr int LDS_BYTES = 155648;

__device__ __forceinline__ unsigned f2bf(float f) { unsigned u = __builtin_bit_cast(unsigned, f); return (u + 0x7fffu + ((u >> 16) & 1u)) >> 16; }
typedef float f32x2 __attribute__((ext_vector_type(2))); typedef __bf16 bf16x2_t __attribute__((ext_vector_type(2)));
__device__ __forceinline__ unsigned pk2(float lo, float hi) { const f32x2 v = {lo, hi}; const bf16x2_t b = __builtin_convertvector(v, bf16x2_t); return __builtin_bit_cast(unsigned, b); }
__device__ __forceinline__ float bf2f(unsigned short h) { return __builtin_bit_cast(float, (unsigned)h << 16); }
__device__ __forceinline__ float bflo(unsigned w) { return __builtin_bit_cast(float, w << 16); }
__device__ __forceinline__ float bfhi(unsigned w) { return __builtin_bit_cast(float, w & 0xffff0000u); }
__device__ __forceinline__ float wave_sum(float v) {
#pragma unroll
    for (int o = 1; o < 64; o <<= 1) v += __shfl_xor(v, o);
    return v;
}

namespace pg8 {
constexpr int BM = 256, BK = 64, HALF = 128, HTB = HALF * BK * 2, STAGE_BYTES = 8 * HTB, NXCD = 8, WGM = 8;
__host__ __device__ __forceinline__ int lds_byte(int r, int c) { const int st = (r >> 4) * 2 + (c >> 5), rr = r & 15, cc = c & 31, ob = rr * 64 + cc * 2; return st * 1024 + (ob ^ (((ob >> 9) & 1) << 5)); }
__host__ __device__ __forceinline__ void stage_rc(int b, int& R, int& C) { const int st = b / 1024, sb = b % 1024, swz = sb ^ (((sb >> 9) & 1) << 5); R = (st >> 1) * 16 + swz / 64; C = (st & 1) * 32 + (swz % 64) / 2; }
__host__ __device__ __forceinline__ int perm32(int rho) { const int n = rho >> 4, i = rho & 15; return 8 * (i >> 2) + 4 * n + (i & 3); }
struct Unit { int pm, pn; };
struct Gemm { const bf16_t* A; const bf16_t* Bt; int M, N, K; };
struct StaticOrder {
    int nM, nN, nwg, G, c;
    __host__ __device__ void init(int M, int N, int G_, int c_) { nM = M / BM; nN = N / BM; nwg = nM * nN; G = G_; c = c_; }
    __host__ __device__ bool next(int i, Unit& u) const {
        const long L = (long)i * G + c; if (L >= nwg) return false;
        int wgid = (int)L; { const int q = nwg / NXCD, r = nwg % NXCD, xcd = wgid % NXCD, off = wgid / NXCD; wgid = (xcd < r ? xcd * (q + 1) : r * (q + 1) + (xcd - r) * q) + off; }
        const int nig = WGM * nN, gid = wgid / nig, fm = gid * WGM, gsz = (nM - fm) < WGM ? (nM - fm) : WGM;
        u.pm = fm + ((wgid % nig) % gsz); u.pn = (wgid % nig) / gsz; return true;
    }
    __device__ __forceinline__ void a_ready(const Unit&) const {}
    __device__ __forceinline__ void done(const Unit&) const {}
};
struct EpiBf16Plain {
    static constexpr bool PERM = true, AFTER_DRAIN = false, FUSED_LDS = false; static constexpr int HALF_B_TILE = -1;
    bf16_t* O; int ldc;
    __device__ __forceinline__ void operator()(const f32x4 (&acc)[2][2][4][2], const Unit& u, int wr, int wc, int fr, int fq) const {
        const int row0 = u.pm * BM + wr * 64 + fr; const int col0 = u.pn * BM + wc * 64 + 8 * fq;
#pragma unroll
        for (int ai = 0; ai < 2; ++ai)
#pragma unroll
            for (int m = 0; m < 4; ++m) { bf16_t* rowp = O + (size_t)(row0 + ai * HALF + m * 16) * ldc + col0;
#pragma unroll
                for (int bj = 0; bj < 2; ++bj) { const f32x4 v0 = acc[ai][bj][m][0], v1 = acc[ai][bj][m][1];
                    u32x4 w; w.x = pk2(v0[0], v0[1]); w.y = pk2(v0[2], v0[3]); w.z = pk2(v1[0], v1[1]); w.w = pk2(v1[2], v1[3]);
                    *(u32x4*)(rowp + bj * 32) = w; } }
    }
};

template <class Epi, class Sched, bool ALIGN_EPI = false, bool SP2 = false>
__device__ __forceinline__ void gemm_phase(LAS unsigned char* lds, const Gemm g, const Sched& S, const Epi& E, const int tid) {
    const int wid = __builtin_amdgcn_readfirstlane(tid >> 6), lane = tid & 63, wr = wid >> 2, wc = wid & 3, fr = lane & 15, fq = lane >> 4;
    const int K = g.K, nt = K / BK;
    unsigned voffA[2], voffB[2];
#pragma unroll
    for (int i = 0; i < 2; ++i) { int R, C; stage_rc(tid * 16 + i * 8192, R, C); const int Rb = 64 * (R >> 5) + perm32(R & 31);
        voffA[i] = (unsigned)(R * K + C) * 2u; voffB[i] = (unsigned)(Rb * K + C) * 2u; }
    const size_t kstep = (size_t)(BK * 2);
    const size_t hstep = (size_t)HALF * K * 2;
    const size_t hstepB = (size_t)32 * K * 2;
    const size_t tstep = 2 * hstep;
    const unsigned ldsw = (unsigned)wid * 1024u;
    const int aoff = lds_byte(wr * 64 + fr, fq * 8), boff = lds_byte(wc * 32 + fr, fq * 8);
#define PG8_SA(b, h) (((b) * 2 + (h)) * HTB)
#define PG8_SB(b, h) ((4 + (b) * 2 + (h)) * HTB)
#define PG8_STAGE(bufoff, gbase, voff) do { _Pragma("unroll") for (int _i = 0; _i < 2; ++_i) \
        __builtin_amdgcn_global_load_lds((const unsigned*)((const char*)(gbase) + (voff)[_i]), (LAS unsigned*)(lds + (bufoff) + ldsw + _i * 8192), 16, 0, 0); } while (0)
#define PG8_LDA(dst, b, h) do { _Pragma("unroll") for (int m = 0; m < 4; ++m) _Pragma("unroll") for (int k = 0; k < 2; ++k) dst[m][k] = *(const LAS bf16x8*)(lds + PG8_SA(b, h) + aoff + m * 2048 + k * 1024); } while (0)
#define PG8_LDB(dst, b, h) do { _Pragma("unroll") for (int n = 0; n < 2; ++n) _Pragma("unroll") for (int k = 0; k < 2; ++k) dst[n][k] = *(const LAS bf16x8*)(lds + PG8_SB(b, h) + boff + n * 2048 + k * 1024); } while (0)
#define PG8_MMA(ai, bj, At, Bt) do { __builtin_amdgcn_s_setprio(1); _Pragma("unroll") for (int m = 0; m < 4; ++m) _Pragma("unroll") for (int n = 0; n < 2; ++n) _Pragma("unroll") for (int k = 0; k < 2; ++k) \
        acc[ai][bj][m][n] = __builtin_amdgcn_mfma_f32_16x16x32_bf16(Bt[n][k], At[m][k], acc[ai][bj][m][n], 0, 0, 0); __builtin_amdgcn_s_setprio(0); } while (0)
#define PG8_WAIT_V(n) asm volatile("s_waitcnt vmcnt(" #n ")" ::: "memory")
#define PG8_WAIT_L(n) asm volatile("s_waitcnt lgkmcnt(" #n ")" ::: "memory")
#define PG8_BAR __builtin_amdgcn_s_barrier()
#define PG8_SCHED __builtin_amdgcn_sched_barrier(0)
    Unit cur, nxt; int ui = 0;
    if (!S.next(0, cur)) return;
    f32x4 acc[2][2][4][2];
#pragma unroll
    for (int a = 0; a < 2; ++a)
#pragma unroll
        for (int b = 0; b < 2; ++b)
#pragma unroll
            for (int m = 0; m < 4; ++m)
#pragma unroll
                for (int n = 0; n < 2; ++n) acc[a][b][m][n] = (f32x4){0.f, 0.f, 0.f, 0.f};
    bf16x8 At[4][2], B0[2][2], B1[2][2];
    const char* cA = (const char*)g.A + (size_t)cur.pm * tstep; const char* cB = (const char*)g.Bt + (size_t)cur.pn * tstep;
    S.a_ready(cur);
    if constexpr (SP2) {
        PG8_STAGE(PG8_SB(0, 0), cB, voffB); PG8_STAGE(PG8_SB(0, 1), cB + hstepB, voffB); PG8_STAGE(PG8_SA(0, 0), cA, voffA); PG8_STAGE(PG8_SA(0, 1), cA + hstep, voffA);
        if (wr == 1) PG8_BAR;
        PG8_WAIT_V(2); PG8_BAR;
        PG8_STAGE(PG8_SB(1, 0), cB + kstep, voffB); PG8_STAGE(PG8_SA(1, 0), cA + kstep, voffA); PG8_STAGE(PG8_SB(1, 1), cB + hstepB + kstep, voffB);
        PG8_WAIT_V(6); PG8_BAR;
    } else {
        PG8_STAGE(PG8_SB(0, 0), cB, voffB); PG8_STAGE(PG8_SA(0, 0), cA, voffA); PG8_STAGE(PG8_SB(0, 1), cB + hstepB, voffB); PG8_STAGE(PG8_SA(0, 1), cA + hstep, voffA);
        if (wr == 1) PG8_BAR;
        PG8_WAIT_V(4); PG8_BAR;
        PG8_STAGE(PG8_SB(1, 0), cB + kstep, voffB); PG8_STAGE(PG8_SA(1, 0), cA + kstep, voffA); PG8_STAGE(PG8_SB(1, 1), cB + hstepB + kstep, voffB);
        PG8_WAIT_V(6); PG8_BAR;
    }
    for (;;) {
        const bool has_next = S.next(ui + 1, nxt);
        const bool useB1 = (Epi::HALF_B_TILE < 0) || (cur.pn != Epi::HALF_B_TILE);
        const char* nA = has_next ? (const char*)g.A + (size_t)nxt.pm * tstep : cA; const char* nB = has_next ? (const char*)g.Bt + (size_t)nxt.pn * tstep : cB;
        for (int t = 0; t < nt; t += 2) {
            const bool last = (t == nt - 2);
            const char* a1 = cA + (size_t)(t + 1) * kstep;
            const char* a2 = last ? nA : cA + (size_t)(t + 2) * kstep; const char* b2 = last ? nB : cB + (size_t)(t + 2) * kstep;
            const char* a3 = a2 + kstep; const char* b3 = b2 + kstep;
            if (last && has_next) S.a_ready(nxt);
            if constexpr (SP2) {
            PG8_LDB(B0, 0, 0); if (useB1) PG8_LDB(B1, 0, 1); PG8_SCHED; PG8_LDA(At, 0, 0); PG8_STAGE(PG8_SA(1, 1), a1 + hstep, voffA);
            PG8_WAIT_V(8); PG8_WAIT_L(0); PG8_BAR; PG8_MMA(0, 0, At, B0); if (useB1) PG8_MMA(0, 1, At, B1); PG8_BAR; PG8_SCHED;
            PG8_LDA(At, 0, 1); PG8_STAGE(PG8_SB(0, 0), b2, voffB); PG8_STAGE(PG8_SB(0, 1), b2 + hstepB, voffB); PG8_STAGE(PG8_SA(0, 0), a2, voffA);
            PG8_WAIT_V(8); PG8_WAIT_L(0); PG8_BAR; PG8_MMA(1, 0, At, B0); if (useB1) PG8_MMA(1, 1, At, B1); PG8_BAR; PG8_SCHED;
            PG8_LDB(B0, 1, 0); if (useB1) PG8_LDB(B1, 1, 1); PG8_SCHED; PG8_LDA(At, 1, 0); PG8_STAGE(PG8_SA(0, 1), a2 + hstep, voffA);
            PG8_WAIT_V(8); PG8_WAIT_L(0); PG8_BAR; PG8_MMA(0, 0, At, B0); if (useB1) PG8_MMA(0, 1, At, B1); PG8_BAR; PG8_SCHED;
            PG8_LDA(At, 1, 1); PG8_STAGE(PG8_SB(1, 0), b3, voffB); PG8_STAGE(PG8_SB(1, 1), b3 + hstepB, voffB); PG8_STAGE(PG8_SA(1, 0), a3, voffA);
            PG8_WAIT_V(8); PG8_WAIT_L(0); PG8_BAR; PG8_MMA(1, 0, At, B0); if (useB1) PG8_MMA(1, 1, At, B1); PG8_BAR; PG8_SCHED;
            } else {
            PG8_LDB(B0, 0, 0); PG8_SCHED; PG8_LDA(At, 0, 0); PG8_STAGE(PG8_SA(1, 1), a1 + hstep, voffA);
            PG8_WAIT_L(8); PG8_BAR; PG8_WAIT_L(0); PG8_MMA(0, 0, At, B0); PG8_BAR; PG8_SCHED;
            PG8_LDB(B1, 0, 1); PG8_STAGE(PG8_SB(0, 0), b2, voffB);
            PG8_BAR; PG8_WAIT_L(0); PG8_MMA(0, 1, At, B1); PG8_BAR;
            PG8_LDA(At, 0, 1); PG8_STAGE(PG8_SA(0, 0), a2, voffA);
            PG8_BAR; PG8_WAIT_L(0); PG8_MMA(1, 0, At, B0); PG8_BAR; PG8_SCHED;
            PG8_STAGE(PG8_SB(0, 1), b2 + hstepB, voffB);
            PG8_WAIT_V(6); PG8_BAR; PG8_MMA(1, 1, At, B1); PG8_BAR;
            PG8_LDB(B0, 1, 0); PG8_SCHED; PG8_LDA(At, 1, 0); PG8_STAGE(PG8_SA(0, 1), a2 + hstep, voffA);
            PG8_WAIT_L(8); PG8_BAR; PG8_WAIT_L(0); PG8_MMA(0, 0, At, B0); PG8_BAR; PG8_SCHED;
            PG8_LDB(B1, 1, 1); PG8_STAGE(PG8_SB(1, 0), b3, voffB);
            PG8_BAR; PG8_WAIT_L(0); PG8_MMA(0, 1, At, B1); PG8_BAR;
            PG8_LDA(At, 1, 1); PG8_STAGE(PG8_SA(1, 0), a3, voffA);
            PG8_BAR; PG8_WAIT_L(0); PG8_MMA(1, 0, At, B0); PG8_BAR; PG8_SCHED;
            PG8_STAGE(PG8_SB(1, 1), b3 + hstepB, voffB);
            PG8_WAIT_V(6); PG8_BAR; PG8_MMA(1, 1, At, B1); PG8_BAR;
            }
        }
        if constexpr (ALIGN_EPI) { if (wr == 0) PG8_BAR; }
        if constexpr (Epi::FUSED_LDS) { E.fused(acc, cur, wr, wc, fr, fq, lds + STAGE_BYTES, wid, lane); S.done(cur); }
        else if constexpr (!Epi::AFTER_DRAIN) { E(acc, cur, wr, wc, fr, fq); S.done(cur); }
        if (!has_next) break;
#pragma unroll
        for (int a = 0; a < 2; ++a)
#pragma unroll
            for (int b = 0; b < 2; ++b)
#pragma unroll
                for (int m = 0; m < 4; ++m)
#pragma unroll
                    for (int n = 0; n < 2; ++n) acc[a][b][m][n] = (f32x4){0.f, 0.f, 0.f, 0.f};
        cur = nxt; cA = nA; cB = nB; ++ui;
        if constexpr (ALIGN_EPI) { if (wr == 1) PG8_BAR; }
    }
    PG8_WAIT_V(0);
    if constexpr (!ALIGN_EPI) { if (wr == 0) PG8_BAR; }
    PG8_BAR;
#undef PG8_SA
#undef PG8_SB
#undef PG8_STAGE
#undef PG8_LDA
#undef PG8_LDB
#undef PG8_MMA
#undef PG8_WAIT_V
#undef PG8_WAIT_L
#undef PG8_BAR
#undef PG8_SCHED
}
}

struct EpiInProj {
    static constexpr bool PERM = true, AFTER_DRAIN = false, FUSED_LDS = true; static constexpr int HALF_B_TILE = 18;
    unsigned char* ws; const float *iknw, *iknb;
    template <int KIND>
    __device__ __forceinline__ void tile(const f32x4 (&acc)[2][2][4][2], size_t wsoff, int ldc, int colt, float sc, int row0, int wc, int fq) const {
        bf16_t* base = (bf16_t*)(ws + wsoff);
        const float* rstd = (const float*)(ws + WS_TAB + TB_RSTD);
        const float* ctab = (const float*)(ws + WS_TAB + (KIND == 2 ? TB_CS128 : TB_CS64)); const float* stab = (const float*)(ws + WS_TAB + (KIND == 2 ? TB_SN128 : TB_SN64));
        constexpr bool ROPE = (KIND == 1 || KIND == 2);
        const bool rot = (KIND == 1) ? true : (KIND == 2 ? ((wc & 1) == 0) : false);
        float rs8[8];
#pragma unroll
        for (int g = 0; g < 8; ++g) rs8[g] = rstd[row0 + (g >> 2) * 128 + (g & 3) * 16];
        f32x4 c0, c1, s0, s1;
        const int tstride = (KIND == 2) ? 16 : 8, toff = (KIND == 2) ? 8 * (fq & 1) : 0;
        if (ROPE && rot) { const int o = (row0 & (SEQ - 1)) * tstride + toff; c0 = *(const f32x4*)(ctab + o); c1 = *(const f32x4*)(ctab + o + 4); s0 = *(const f32x4*)(stab + o); s1 = *(const f32x4*)(stab + o + 4); }
#pragma unroll
        for (int g = 0; g < 8; ++g) {
            const int ai = g >> 2, m = g & 3;
            const int row = row0 + ai * 128 + m * 16; const float rs = rs8[g] * sc;
            f32x4 v[2][2];
#pragma unroll
            for (int bj = 0; bj < 2; ++bj) { v[bj][0] = acc[ai][bj][m][0] * rs; v[bj][1] = acc[ai][bj][m][1] * rs; }
            if (ROPE && rot) {
                const bool neg = (KIND == 1) ? (fq == 0) : (fq < 2); const bool idn = (KIND == 1) && (fq >= 2);
                const f32x4 cc0 = idn ? (f32x4){1.f, 1.f, 1.f, 1.f} : c0, cc1 = idn ? (f32x4){1.f, 1.f, 1.f, 1.f} : c1;
                const f32x4 ss0 = idn ? (f32x4){0.f, 0.f, 0.f, 0.f} : (neg ? -s0 : s0), ss1 = idn ? (f32x4){0.f, 0.f, 0.f, 0.f} : (neg ? -s1 : s1);
                {
                    f32x4 p0, p1;
#pragma unroll
                    for (int e = 0; e < 4; ++e) { p0[e] = __shfl_xor(v[0][0][e], KIND == 1 ? 16 : 32); p1[e] = __shfl_xor(v[0][1][e], KIND == 1 ? 16 : 32); }
                    v[0][0] = v[0][0] * cc0 + p0 * ss0; v[0][1] = v[0][1] * cc1 + p1 * ss1;
                }
                if (g < 7) { const int rn = row0 + ((g + 1) >> 2) * 128 + ((g + 1) & 3) * 16; const int o = (rn & (SEQ - 1)) * tstride + toff;
                    c0 = *(const f32x4*)(ctab + o); c1 = *(const f32x4*)(ctab + o + 4); s0 = *(const f32x4*)(stab + o); s1 = *(const f32x4*)(stab + o + 4); }
            }
            const unsigned roff = (unsigned)(row * ldc + colt + wc * 64 + 8 * fq) * 2u;
#pragma unroll
            for (int bj = 0; bj < 2; ++bj) {
                f32x4 v0 = v[bj][0], v1 = v[bj][1];
                if (KIND == 3) {
#pragma unroll
                    for (int e = 0; e < 4; ++e) { v0[e] = v0[e] * __builtin_amdgcn_rcpf(1.f + __builtin_amdgcn_exp2f(-LOG2E * v0[e])); v1[e] = v1[e] * __builtin_amdgcn_rcpf(1.f + __builtin_amdgcn_exp2f(-LOG2E * v1[e])); }
                }
                u32x4 w; w.x = pk2(v0[0], v0[1]); w.y = pk2(v0[2], v0[3]); w.z = pk2(v1[0], v1[1]); w.w = pk2(v1[2], v1[3]);
                *(u32x4*)((unsigned char*)base + roff + bj * 64) = w;
            }
            asm volatile("" ::: "memory");
        }
    }
    __device__ __forceinline__ void fused(f32x4 (&acc)[2][2][4][2], const pg8::Unit& u, int wr, int wc, int fr_, int fq_, LAS unsigned char* scr, int wid, int lane) const {
        int fr = fr_, fq = fq_; asm volatile("" : "+v"(fr), "+v"(fq));
        const int pn = u.pn;
        const int row0 = u.pm * 256 + wr * 64 + fr;
        if (pn < 18) {
            const int grp = pn >> 1; const int colt = (pn & 1) * 256;
            switch (grp) {
                case 0: tile<1>(acc, WS_QMIX, 1024, colt, 0.125f * LOG2E, row0, wc, fq); break;
                case 1: tile<1>(acc, WS_DK, 512, colt, 1.f, row0, wc, fq); break;
                case 2: tile<0>(acc, WS_DV, 512, colt, 1.f, row0, wc, fq); break;
                case 3: tile<3>(acc, WS_DG, 512, colt, 1.f, row0, wc, fq); break;
                case 4: tile<2>(acc, WS_QMIX, 1024, colt + 512, 0.08838834764831845f * LOG2E, row0, wc, fq); break;
                case 5: tile<2>(acc, WS_SK, 512, colt, 1.f, row0, wc, fq); break;
                case 6: tile<0>(acc, WS_SV, 512, colt, 1.f, row0, wc, fq); break;
                case 7: tile<3>(acc, WS_SG, 512, colt, 1.f, row0, wc, fq); break;
                default: tile<1>(acc, WS_IQ, 512, colt, 1.f, row0, wc, fq); break;
            }
        } else {
            const float* rstd = (const float*)(ws + WS_TAB + TB_RSTD); const float* cs64 = (const float*)(ws + WS_TAB + TB_CS64); const float* sn64 = (const float*)(ws + WS_TAB + TB_SN64);
            bf16_t* IK = (bf16_t*)(ws + WS_IK); float* IW = (float*)(ws + WS_IW);
            LAS float* T = (LAS float*)scr;
            float rs8[8];
#pragma unroll
            for (int g = 0; g < 8; ++g) rs8[g] = rstd[row0 + (g >> 2) * 128 + (g & 3) * 16];
            if (wc < 2) {
#pragma unroll
                for (int g = 0; g < 8; ++g) { const int ai = g >> 2, m = g & 3; const f32x4 v0 = acc[ai][0][m][0] * rs8[g], v1 = acc[ai][0][m][1] * rs8[g];
                    float s = (v0[0] + v0[1]) + (v0[2] + v0[3]) + (v1[0] + v1[1]) + (v1[2] + v1[3]);
                    float q = (v0[0] * v0[0] + v0[1] * v0[1]) + (v0[2] * v0[2] + v0[3] * v0[3]) + (v1[0] * v1[0] + v1[1] * v1[1]) + (v1[2] * v1[2] + v1[3] * v1[3]);
                    s += __shfl_xor(s, 16); s += __shfl_xor(s, 32); q += __shfl_xor(q, 16); q += __shfl_xor(q, 32);
                    if (fq == 0) { const int lr = ai * 128 + wr * 64 + m * 16 + fr; T[(lr * 2 + wc) * 2] = s; T[(lr * 2 + wc) * 2 + 1] = q; } }
            }
            asm volatile("s_waitcnt lgkmcnt(0)" ::: "memory"); __builtin_amdgcn_s_barrier(); asm volatile("" ::: "memory");
            if (wc < 2) {
                const f32x4 w0 = *(const f32x4*)(iknw + 32 * wc + 8 * fq), w1 = *(const f32x4*)(iknw + 32 * wc + 8 * fq + 4), b0 = *(const f32x4*)(iknb + 32 * wc + 8 * fq), b1 = *(const f32x4*)(iknb + 32 * wc + 8 * fq + 4);
#pragma unroll
                for (int g = 0; g < 8; ++g) { const int ai = g >> 2, m = g & 3; const int lr = ai * 128 + wr * 64 + m * 16 + fr; const int row = u.pm * 256 + lr; const int sp = row & (SEQ - 1);
                    const float s = T[lr * 4] + T[lr * 4 + 2], q = T[lr * 4 + 1] + T[lr * 4 + 3];
                    const float mu = s * (1.f / 64.f), var = fmaxf(q * (1.f / 64.f) - mu * mu, 0.f), rsd = rsqrtf(var + 1e-6f);
                    f32x4 v0 = (acc[ai][0][m][0] * rs8[g] - mu) * rsd * w0 + b0, v1 = (acc[ai][0][m][1] * rs8[g] - mu) * rsd * w1 + b1;
                    if (wc == 0) {
                        const f32x4 c0 = *(const f32x4*)(cs64 + sp * 8), c1 = *(const f32x4*)(cs64 + sp * 8 + 4), s0 = *(const f32x4*)(sn64 + sp * 8), s1 = *(const f32x4*)(sn64 + sp * 8 + 4);
                        f32x4 p0, p1;
#pragma unroll
                        for (int e = 0; e < 4; ++e) { p0[e] = __shfl_xor(v0[e], 16); p1[e] = __shfl_xor(v1[e], 16); }
                        if (fq == 0) { v0 = v0 * c0 - p0 * s0; v1 = v1 * c1 - p1 * s1; }
                        else if (fq == 1) { v0 = v0 * c0 + p0 * s0; v1 = v1 * c1 + p1 * s1; }
                    }
                    u32x4 w; w.x = pk2(v0[0], v0[1]); w.y = pk2(v0[2], v0[3]); w.z = pk2(v1[0], v1[1]); w.w = pk2(v1[2], v1[3]);
                    *(u32x4*)(IK + (size_t)row * 64 + 32 * wc + 8 * fq) = w;
                    asm volatile("" ::: "memory"); }
            } else if (wc == 2) {
                if (fq == 0) {
#pragma unroll
                    for (int g = 0; g < 8; ++g) { const int ai = g >> 2, m = g & 3; const int row = row0 + ai * 128 + m * 16; const float rs = rs8[g] * 0.04419417382415922f;
                        *(f32x4*)(IW + (size_t)row * 8) = acc[ai][0][m][0] * rs; *(f32x4*)(IW + (size_t)row * 8 + 4) = acc[ai][0][m][1] * rs; }
                }
            }
            asm volatile("s_waitcnt lgkmcnt(0)" ::: "memory"); __builtin_amdgcn_s_barrier(); asm volatile("" ::: "memory");
        }
    }
};

constexpr int CW_XCNT = 16384;
constexpr size_t WS_XSLOT = 413 * MiB;
struct EpiOutNorm {
    static constexpr bool PERM = true, AFTER_DRAIN = false, FUSED_LDS = true; static constexpr int HALF_B_TILE = -1;
    unsigned char* ws; const float* post_w; float* out; int layer; bool last;
    __device__ __forceinline__ void exchange(const float (&part)[8], int e, const pg8::Unit& u, int wr, int wc, int fr, int fq, LAS unsigned char* scr, int wid, int lane, float scale_eps_unused) const {
        LAS float* Pt = (LAS float*)scr;
        LAS float* St = (LAS float*)(scr + 4096);
        float* slots = (float*)(ws + WS_XSLOT) + (size_t)(layer * 2 + e) * MTOK * 4;
        unsigned* cnt = (unsigned*)(ws + WS_CTL) + CW_XCNT + ((layer * 2 + e) * 128 + u.pm) * 64;
#pragma unroll
        for (int g = 0; g < 8; ++g) { float q = part[g]; q += __shfl_xor(q, 16); q += __shfl_xor(q, 32); if (fq == 0) Pt[((g >> 2) * 128 + wr * 64 + (g & 3) * 16 + fr) * 4 + wc] = q; }
        asm volatile("s_waitcnt lgkmcnt(0)" ::: "memory"); __builtin_amdgcn_s_barrier(); asm volatile("" ::: "memory");
        const int row = wid * 32 + (lane & 31);
        if (lane < 32) { const float t = (Pt[row * 4 + 0] + Pt[row * 4 + 1]) + (Pt[row * 4 + 2] + Pt[row * 4 + 3]);
            __hip_atomic_store(slots + ((size_t)(u.pm * 256 + row) * 4 + u.pn), t, __ATOMIC_RELAXED, __HIP_MEMORY_SCOPE_AGENT); }
        asm volatile("s_waitcnt vmcnt(0)" ::: "memory");
        if (lane == 0) __hip_atomic_fetch_add(cnt, 1u, __ATOMIC_RELAXED, __HIP_MEMORY_SCOPE_AGENT);
        if (wid == 0) {
            unsigned sp = 0;
            while ((unsigned)__builtin_amdgcn_readfirstlane((int)__hip_atomic_load(cnt, __ATOMIC_RELAXED, __HIP_MEMORY_SCOPE_AGENT)) < 32u) { __builtin_amdgcn_s_sleep(2); if (++sp > (1u << 22)) break; }
            __builtin_amdgcn_fence(__ATOMIC_ACQUIRE, "agent");
        }
        asm volatile("s_waitcnt vmcnt(0) lgkmcnt(0)" ::: "memory"); __builtin_amdgcn_s_barrier(); asm volatile("" ::: "memory");
        if (lane < 32) { const float* sl = slots + (size_t)(u.pm * 256 + row) * 4; float t = 0.f;
#pragma unroll
            for (int k = 0; k < 4; ++k) t += __hip_atomic_load(sl + k, __ATOMIC_RELAXED, __HIP_MEMORY_SCOPE_AGENT);
            St[row] = t; }
        asm volatile("s_waitcnt vmcnt(0) lgkmcnt(0)" ::: "memory"); __builtin_amdgcn_s_barrier(); asm volatile("" ::: "memory");
    }
    __device__ __forceinline__ void fused(f32x4 (&acc)[2][2][4][2], const pg8::Unit& u, int wr, int wc, int fr_, int fq_, LAS unsigned char* scr, int wid, int lane) const {
        int fr = fr_, fq = fq_; asm volatile("" : "+v"(fr), "+v"(fq));
        LAS float* St = (LAS float*)(scr + 4096);
        bf16_t* XB = (bf16_t*)(ws + WS_XB); float* RSTD = (float*)(ws + WS_TAB + TB_RSTD);
        const int row0 = u.pm * 256 + wr * 64 + fr; const int col0 = u.pn * 256 + wc * 64 + 8 * fq;
        u32x4 xr[4][2];
#pragma unroll
        for (int g = 0; g < 4; ++g)
#pragma unroll
            for (int bj = 0; bj < 2; ++bj) xr[g][bj] = *(const u32x4*)(XB + (size_t)(row0 + (g >> 2) * 128 + (g & 3) * 16) * DM + col0 + bj * 32);
        f32x4 pw[2][2];
#pragma unroll
        for (int bj = 0; bj < 2; ++bj)
#pragma unroll
            for (int n = 0; n < 2; ++n) pw[bj][n] = *(const f32x4*)(post_w + col0 + bj * 32 + 4 * n);
        float part[8];
#pragma unroll
        for (int g = 0; g < 8; ++g) { const int ai = g >> 2, m = g & 3; float q = 0.f;
#pragma unroll
            for (int bj = 0; bj < 2; ++bj)
#pragma unroll
                for (int n = 0; n < 2; ++n) { const f32x4 v = acc[ai][bj][m][n]; q += (v[0] * v[0] + v[1] * v[1]) + (v[2] * v[2] + v[3] * v[3]); }
            part[g] = q; }
        exchange(part, 0, u, wr, wc, fr, fq, scr, wid, lane, 0.f);
#pragma unroll
        for (int g = 0; g < 8; ++g) { const int ai = g >> 2, m = g & 3; const int lr = ai * 128 + wr * 64 + m * 16 + fr;
            const float ry = rsqrtf(St[lr] * (1.f / DM) + 1e-6f); float q = 0.f;
#pragma unroll
            for (int bj = 0; bj < 2; ++bj) { const u32x4 xv = xr[g & 3][bj];
                f32x4 x0 = (f32x4){bflo(xv.x), bfhi(xv.x), bflo(xv.y), bfhi(xv.y)}, x1 = (f32x4){bflo(xv.z), bfhi(xv.z), bflo(xv.w), bfhi(xv.w)};
                x0 = x0 + acc[ai][bj][m][0] * ry * pw[bj][0]; x1 = x1 + acc[ai][bj][m][1] * ry * pw[bj][1];
                acc[ai][bj][m][0] = x0; acc[ai][bj][m][1] = x1;
                q += (x0[0] * x0[0] + x0[1] * x0[1]) + (x0[2] * x0[2] + x0[3] * x0[3]) + (x1[0] * x1[0] + x1[1] * x1[1]) + (x1[2] * x1[2] + x1[3] * x1[3]); }
            part[g] = q;
            if (g < 4) {
#pragma unroll
                for (int bj = 0; bj < 2; ++bj) xr[g][bj] = *(const u32x4*)(XB + (size_t)(row0 + 128 + g * 16) * DM + col0 + bj * 32);
            } }
        if (last) {
#pragma unroll
            for (int g = 0; g < 8; ++g) { const int ai = g >> 2, m = g & 3; const size_t off = (size_t)(row0 + ai * 128 + m * 16) * DM + col0;
#pragma unroll
                for (int bj = 0; bj < 2; ++bj) { *(f32x4*)(out + off + bj * 32) = acc[ai][bj][m][0]; *(f32x4*)(out + off + bj * 32 + 4) = acc[ai][bj][m][1]; } }
        } else {
            exchange(part, 1, u, wr, wc, fr, fq, scr, wid, lane, 0.f);
            if (u.pn == 0 && lane < 32) { const int row = wid * 32 + lane; RSTD[u.pm * 256 + row] = rsqrtf(St[row] * (1.f / DM) + 1e-6f); }
#pragma unroll
            for (int g = 0; g < 8; ++g) { const int ai = g >> 2, m = g & 3; const size_t off = (size_t)(row0 + ai * 128 + m * 16) * DM + col0;
#pragma unroll
                for (int bj = 0; bj < 2; ++bj) { const f32x4 v0 = acc[ai][bj][m][0], v1 = acc[ai][bj][m][1];
                    u32x4 w; w.x = pk2(v0[0], v0[1]); w.y = pk2(v0[2], v0[3]); w.z = pk2(v1[0], v1[1]); w.w = pk2(v1[2], v1[3]);
                    *(u32x4*)(XB + off + bj * 32) = w; } }
        }
    }
};

struct Params {
    const float* x; const int* positions; const float* pre_w; const float* post_w; const float* w_in; const float* w_out;
    const float *lq1, *lk1, *lq2, *lk2; const float* subln_w; const float* iknw; const float* iknb;
    float* out; unsigned char* ws;
};

__device__ __forceinline__ int win_src(int n) {
    if (n < 4608) return n;
    const int p = n - 4608;
    if (p < 32) return 4608 + p;
    if (p >= 64 && p < 96) return 4608 + 32 + (p - 64);
    if (p >= 128 && p < 136) return 4672 + (p - 128);
    return -1;
}

__device__ __forceinline__ void transpose_item(const float* W, int ldw, const float* scale  , bool mapped, bf16_t* WT, LAS float* scr, int kb, int nb, int lane) {
    const int k0 = 64 * kb, n0 = 32 * nb;
    const int src = mapped ? win_src(n0 + (lane & 31)) : n0 + (lane & 31);
    float v[32];
#pragma unroll
    for (int i = 0; i < 32; ++i) { const int kk = 2 * i + (lane >> 5); v[i] = (src >= 0) ? W[(size_t)(k0 + kk) * ldw + src] : 0.f; }
#pragma unroll
    for (int i = 0; i < 32; ++i) scr[(2 * i + (lane >> 5)) * 33 + (lane & 31)] = v[i];
    asm volatile("s_waitcnt lgkmcnt(0)" ::: "memory");
    const int c = lane & 7;
    f32x4 s0 = (f32x4){1.f, 1.f, 1.f, 1.f}, s1 = s0;
    if (scale) { s0 = *(const f32x4*)(scale + k0 + 8 * c); s1 = *(const f32x4*)(scale + k0 + 8 * c + 4); }
#pragma unroll
    for (int j = 0; j < 4; ++j) { const int n = (lane >> 3) + 8 * j; const LAS float* s = scr + (8 * c) * 33 + n;
        u32x4 o; o.x = pk2(s[0 * 33] * s0[0], s[1 * 33] * s0[1]); o.y = pk2(s[2 * 33] * s0[2], s[3 * 33] * s0[3]); o.z = pk2(s[4 * 33] * s1[0], s[5 * 33] * s1[1]); o.w = pk2(s[6 * 33] * s1[2], s[7 * 33] * s1[3]);
        *(u32x4*)(WT + (size_t)(n0 + n) * 1024 + k0 + 8 * c) = o; }
    asm volatile("s_waitcnt lgkmcnt(0)" ::: "memory");
}

__device__ __forceinline__ void convert_weights(const Params& P, LAS float* scr, int l0, int l1, int w, int nw, int lane) {
    bf16_t* WIN = (bf16_t*)(P.ws + WS_WIN); bf16_t* WOUT = (bf16_t*)(P.ws + WS_WOUT);
    constexpr int I_IN = 16 * (NPAD / 32), I_OUT = 16 * 32, I_L = I_IN + I_OUT;
    for (int it = w; it < (l1 - l0) * I_L; it += nw) {
        const int l = l0 + it / I_L, r = it % I_L;
        if (r < I_IN) transpose_item(P.w_in + (size_t)l * DM * NIN, NIN, P.pre_w + l * DM, true, WIN + (size_t)l * NPAD * DM, scr, r / (NPAD / 32), r % (NPAD / 32), lane);
        else { const int r2 = r - I_IN; transpose_item(P.w_out + (size_t)l * DM * DM, DM, nullptr, false, WOUT + (size_t)l * DM * DM, scr, r2 / 32, r2 % 32, lane); }
    }
}

__device__ __forceinline__ void prep_phase(const Params& P, LAS unsigned char* lds, int tid, int lane, int wave) {
    const int G = gridDim.x; const int gw = blockIdx.x * 8 + wave, NGW = G * 8;
    LAS float* scr = (LAS float*)(lds + wave * 16384);
    bf16_t* XB = (bf16_t*)(P.ws + WS_XB); float* RSTD = (float*)(P.ws + WS_TAB + TB_RSTD);
#pragma unroll 1
    for (int job = 0; job < 2; ++job) {
      if ((job ^ (int)(blockIdx.x & 1)) == 0) {
    convert_weights(P, scr, 0, 1, gw, NGW, lane);
      } else {
    for (int m0 = 4 * gw; m0 < MTOK; m0 += 4 * NGW) {
        f32x4 v[4][4]; float ss[4];
#pragma unroll
        for (int r = 0; r < 4; ++r) { const f32x4* xr = (const f32x4*)(P.x + (size_t)(m0 + r) * DM) + lane;
#pragma unroll
            for (int j = 0; j < 4; ++j) v[r][j] = xr[64 * j]; }
#pragma unroll
        for (int r = 0; r < 4; ++r) { float s = 0.f;
#pragma unroll
            for (int j = 0; j < 4; ++j) s += (v[r][j][0] * v[r][j][0] + v[r][j][1] * v[r][j][1]) + (v[r][j][2] * v[r][j][2] + v[r][j][3] * v[r][j][3]);
            ss[r] = s; }
#pragma unroll
        for (int o = 1; o < 64; o <<= 1) {
#pragma unroll
            for (int r = 0; r < 4; ++r) ss[r] += __shfl_xor(ss[r], o); }
#pragma unroll
        for (int r = 0; r < 4; ++r) { u32x2* o = (u32x2*)(XB + (size_t)(m0 + r) * DM) + lane;
#pragma unroll
            for (int j = 0; j < 4; ++j) { u32x2 w; w.x = pk2(v[r][j][0], v[r][j][1]); w.y = pk2(v[r][j][2], v[r][j][3]); o[64 * j] = w; }
            if (lane == 0) RSTD[m0 + r] = rsqrtf(ss[r] * (1.f / DM) + 1e-6f); }
    }
      }
    }
    float* cs64 = (float*)(P.ws + WS_TAB + TB_CS64); float* sn64 = (float*)(P.ws + WS_TAB + TB_SN64);
    float* cs128 = (float*)(P.ws + WS_TAB + TB_CS128); float* sn128 = (float*)(P.ws + WS_TAB + TB_SN128);
    for (int idx = blockIdx.x * 512 + tid; idx < SEQ * 16; idx += G * 512) {
        const int s = idx >> 4, i = idx & 15; const float pos = (float)P.positions[s];
        { const float inv = powf(500000.0f, -(float)(2 * i) / 32.0f); const float a = pos * inv; cs128[idx] = cosf(a); sn128[idx] = sinf(a); }
        if (i < 8) { const float inv = powf(500000.0f, -(float)(2 * i) / 16.0f); const float a = pos * inv; cs64[s * 8 + i] = cosf(a); sn64[s * 8 + i] = sinf(a); }
    }
    if (blockIdx.x == 0 && wave == 0) {
        float* lam = (float*)(P.ws + WS_TAB + TB_LAM);
        for (int l = 0; l < DEPTH; ++l) {
            const float d1 = wave_sum(P.lq1[l * 64 + lane] * P.lk1[l * 64 + lane]), d2 = wave_sum(P.lq2[l * 64 + lane] * P.lk2[l * 64 + lane]);
            const float li = 0.8f - 0.6f * expf(-0.3f * (float)l);
            if (lane == 0) { lam[2 * l] = expf(d1) - expf(d2) + li; lam[2 * l + 1] = li; }
        }
    }
}

__device__ __forceinline__ void norm_phase(const Params& P, int layer_done  , bool last, int lane, int wave) {
    const int G = gridDim.x; const int gw = blockIdx.x * 8 + wave, NGW = G * 8;
    bf16_t* XB = (bf16_t*)(P.ws + WS_XB); const bf16_t* Y = (const bf16_t*)(P.ws + WS_Y); float* RSTD = (float*)(P.ws + WS_TAB + TB_RSTD);
    const float* pw = P.post_w + layer_done * DM;
    f32x4 w4[4];
#pragma unroll
    for (int i = 0; i < 2; ++i) { w4[2 * i] = *(const f32x4*)(pw + 8 * lane + 512 * i); w4[2 * i + 1] = *(const f32x4*)(pw + 8 * lane + 512 * i + 4); }
    for (int m = gw; m < MTOK; m += NGW) {
        u32x4 yv[2], xv[2];
#pragma unroll
        for (int i = 0; i < 2; ++i) { yv[i] = *(const u32x4*)(Y + (size_t)m * DM + 8 * lane + 512 * i); xv[i] = *(const u32x4*)(XB + (size_t)m * DM + 8 * lane + 512 * i); }
        float yf[16], xf[16]; float s = 0.f;
#pragma unroll
        for (int i = 0; i < 2; ++i)
#pragma unroll
            for (int e = 0; e < 4; ++e) { yf[8 * i + 2 * e] = bflo(yv[i][e]); yf[8 * i + 2 * e + 1] = bfhi(yv[i][e]); xf[8 * i + 2 * e] = bflo(xv[i][e]); xf[8 * i + 2 * e + 1] = bfhi(xv[i][e]); }
#pragma unroll
        for (int k = 0; k < 16; ++k) s += yf[k] * yf[k];
        s = wave_sum(s);
        const float ry = rsqrtf(s * (1.f / DM) + 1e-6f);
        float s2 = 0.f;
#pragma unroll
        for (int k = 0; k < 16; ++k) { xf[k] = xf[k] + yf[k] * ry * w4[k >> 2][k & 3]; s2 += xf[k] * xf[k]; }
        if (last) {
#pragma unroll
            for (int i = 0; i < 2; ++i) { float* o = P.out + (size_t)m * DM + 8 * lane + 512 * i;
                *(f32x4*)o = (f32x4){xf[8 * i], xf[8 * i + 1], xf[8 * i + 2], xf[8 * i + 3]}; *(f32x4*)(o + 4) = (f32x4){xf[8 * i + 4], xf[8 * i + 5], xf[8 * i + 6], xf[8 * i + 7]}; }
        } else {
            s2 = wave_sum(s2);
#pragma unroll
            for (int i = 0; i < 2; ++i) { u32x4 w; w.x = pk2(xf[8 * i], xf[8 * i + 1]); w.y = pk2(xf[8 * i + 2], xf[8 * i + 3]); w.z = pk2(xf[8 * i + 4], xf[8 * i + 5]); w.w = pk2(xf[8 * i + 6], xf[8 * i + 7]);
                *(u32x4*)(XB + (size_t)m * DM + 8 * lane + 512 * i) = w; }
            if (lane == 0) RSTD[m] = rsqrtf(s2 * (1.f / DM) + 1e-6f);
        }
    }
}

constexpr int SC_PITCH = 2052;
__device__ __forceinline__ unsigned sortable(float v) { v = v + 0.0f; const unsigned u = __builtin_bit_cast(unsigned, v); return (u & 0x80000000u) ? ~u : (u | 0x80000000u); }

template <int NJ>
__device__ __forceinline__ int count_ge(const unsigned (&u)[NJ], unsigned cand) {
    static_assert(NJ % 4 == 0, "count_ge: NJ is a multiple of 4");
    unsigned c0 = 0u, c1 = 0u, c2 = 0u, c3 = 0u;
#pragma unroll
    for (int j = 0; j < NJ; j += 4) {
        unsigned long long t0, t1, t2, t3;
        asm volatile("v_cmp_le_u32_e64 %4, %8, %9\n\tv_cmp_le_u32_e64 %5, %8, %10\n\tv_cmp_le_u32_e64 %6, %8, %11\n\tv_cmp_le_u32_e64 %7, %8, %12\n\t"
                     "v_addc_co_u32_e64 %0, %4, 0, %0, %4\n\tv_addc_co_u32_e64 %1, %5, 0, %1, %5\n\tv_addc_co_u32_e64 %2, %6, 0, %2, %6\n\tv_addc_co_u32_e64 %3, %7, 0, %3, %7"
                     : "+v"(c0), "+v"(c1), "+v"(c2), "+v"(c3), "=&s"(t0), "=&s"(t1), "=&s"(t2), "=&s"(t3) : "s"(cand), "v"(u[j]), "v"(u[j + 1]), "v"(u[j + 2]), "v"(u[j + 3]));
    }
    const unsigned cl = (c0 + c1) + (c2 + c3);
    int v = (int)cl;
    v += __builtin_amdgcn_update_dpp(0, v, 0xB1, 0xF, 0xF, false);
    v += __builtin_amdgcn_update_dpp(0, v, 0x4E, 0xF, 0xF, false);
    v += __builtin_amdgcn_update_dpp(0, v, 0x141, 0xF, 0xF, false);
    v += __builtin_amdgcn_update_dpp(0, v, 0x140, 0xF, 0xF, false);
    return (__builtin_amdgcn_readlane(v, 0) + __builtin_amdgcn_readlane(v, 16)) + (__builtin_amdgcn_readlane(v, 32) + __builtin_amdgcn_readlane(v, 48));
}
template <int NJ>
__device__ __forceinline__ unsigned select_row(const LAS float* row, int qpos, int lane) {
    unsigned u[NJ];
#pragma unroll
    for (int j = 0; j < NJ; ++j) { const int key = 64 * j + lane; const float v = row[key]; u[j] = (key <= qpos) ? sortable(v) : 0u; }
    unsigned val = 0u;
#define SEL_PUT(j, m) do { const unsigned long long m_ = (m); const unsigned lo_ = (unsigned)m_, hi_ = (unsigned)(m_ >> 32); \
        asm volatile("s_nop 3\n\tv_writelane_b32 %0, %1, %3\n\tv_writelane_b32 %0, %2, %4" : "+v"(val) : "s"(lo_), "s"(hi_), "n"(2 * (j)), "n"(2 * (j) + 1)); } while (0)
    if (qpos < 256) {
#pragma unroll
        for (int j = 0; j < NJ; ++j) SEL_PUT(j, __ballot(u[j] != 0u));
    } else {
        unsigned T = 0u; bool exact = false;
        for (int bit = 31; bit >= 0; --bit) {
            const unsigned cand = T | (1u << bit);
            const int c = count_ge<NJ>(u, cand);
            if (c >= 256) { T = cand; if (c == 256) { exact = true; break; } }
        }
        if (exact) {
#pragma unroll
            for (int j = 0; j < NJ; ++j) SEL_PUT(j, __ballot(u[j] >= T));
        } else {
            int need = 256 - count_ge<NJ>(u, T + 1u);
#pragma unroll
            for (int j = 0; j < NJ; ++j) {
                unsigned long long e = __ballot(u[j] == T);
                const int cnt = __popcll(e);
                if (cnt > need) { unsigned long long t = e; for (int k = 0; k < need; ++k) t &= t - 1; e ^= t; need = 0; }
                else need -= cnt;
                SEL_PUT(j, e | __ballot(u[j] > T));
            }
        }
    }
#undef SEL_PUT
    return val;
}

constexpr int SEL_HB = 16 * SC_PITCH * 4, SEL_HB_STRIDE = 2560;
constexpr int SEL_MM = SEL_HB + 8 * SEL_HB_STRIDE;
#define DPPI(v, ctrl, rmask) __builtin_amdgcn_update_dpp(0, (v), (ctrl), (rmask), 0xF, false)
__device__ __forceinline__ float wave_maxf(float m) {
    m = fmaxf(m, __int_as_float(DPPI(__float_as_int(m), 0xB1, 0xF))); m = fmaxf(m, __int_as_float(DPPI(__float_as_int(m), 0x4E, 0xF)));
    m = fmaxf(m, __int_as_float(DPPI(__float_as_int(m), 0x141, 0xF))); m = fmaxf(m, __int_as_float(DPPI(__float_as_int(m), 0x140, 0xF)));
    const int i = __float_as_int(m);
    return fmaxf(fmaxf(__int_as_float(__builtin_amdgcn_readlane(i, 0)), __int_as_float(__builtin_amdgcn_readlane(i, 16))),
                 fmaxf(__int_as_float(__builtin_amdgcn_readlane(i, 32)), __int_as_float(__builtin_amdgcn_readlane(i, 48))));
}
template <int NJ>
__device__ __forceinline__ unsigned select_fast(const LAS float* row, int qpos, LAS unsigned char* hb, const LAS float* mm, int lane, bool& ok) {
    float v[NJ];
#pragma unroll
    for (int j = 0; j < NJ; ++j) v[j] = row[64 * j + lane];
    const float mx = mm[0], nmn = mm[1];
    const float range = mx + nmn;
    ok = true;
    if (!(range > 1e-20f) || !(range < 1e30f)) { ok = false; return 0u; }
    const float scale = 511.5f * __builtin_amdgcn_rcpf(range), cc = mx * scale;
    *(LAS u32x4*)(hb + lane * 32) = (u32x4){0u, 0u, 0u, 0u}; *(LAS u32x4*)(hb + lane * 32 + 16) = (u32x4){0u, 0u, 0u, 0u};
    if (lane == 0) *(LAS unsigned*)(hb + 2048) = 0u;
    asm volatile("" ::: "memory");
    unsigned sl[NJ]; const unsigned hbase = (unsigned)(size_t)hb;
#pragma unroll
    for (int j = 0; j < NJ; ++j) {
        const float t = __builtin_fmaf(v[j], -scale, cc);
        unsigned s; asm("v_cvt_u32_f32 %0, %1" : "=v"(s) : "v"(t));
        s = min(s, 511u);
        if (j >= NJ - 4) s = ((64 * j + lane) <= qpos) ? s : 512u;
        s = hbase + 4u * s;
        sl[j] = s;
        __hip_atomic_fetch_add((LAS unsigned*)(size_t)s, 1u, __ATOMIC_RELAXED, __HIP_MEMORY_SCOPE_WAVEFRONT);
    }
    asm volatile("" ::: "memory");
    const u32x4 h0 = *(const LAS u32x4*)(hb + lane * 32), h1 = *(const LAS u32x4*)(hb + lane * 32 + 16);
    int q[8]; q[0] = (int)h0[0]; q[1] = q[0] + (int)h0[1]; q[2] = q[1] + (int)h0[2]; q[3] = q[2] + (int)h0[3];
    q[4] = q[3] + (int)h1[0]; q[5] = q[4] + (int)h1[1]; q[6] = q[5] + (int)h1[2]; q[7] = q[6] + (int)h1[3];
    int incl = q[7];
    incl += DPPI(incl, 0x111, 0xF); incl += DPPI(incl, 0x112, 0xF); incl += DPPI(incl, 0x114, 0xF); incl += DPPI(incl, 0x118, 0xF);
    incl += DPPI(incl, 0x142, 0xA); incl += DPPI(incl, 0x143, 0xC);
    const int excl = incl - q[7];
    const int L = __builtin_ctzll(__ballot(incl >= 256));
    int kk = 0, A = excl, B = incl;
#pragma unroll
    for (int k = 0; k < 8; ++k) { const bool lt = (excl + q[k]) < 256; kk += lt ? 1 : 0; A = lt ? excl + q[k] : A; }
#pragma unroll
    for (int k = 6; k >= 0; --k) { const bool lt = (excl + q[k]) < 256; B = lt ? B : excl + q[k]; }
    const int k1 = __builtin_amdgcn_readlane(kk, L), A1 = __builtin_amdgcn_readlane(A, L), B1 = __builtin_amdgcn_readlane(B, L);
    const unsigned p1 = hbase + 4u * (unsigned)(8 * L + k1); const int need = 256 - A1, cnt = B1 - A1;
    if (cnt != need && cnt > 64) { ok = false; return 0u; }
    unsigned val = 0u;
#define SEL_PUT(j, m) do { const unsigned long long m_ = (m); const unsigned lo_ = (unsigned)m_, hi_ = (unsigned)(m_ >> 32); \
        asm volatile("s_nop 1\n\tv_writelane_b32 %0, %1, %3\n\tv_writelane_b32 %0, %2, %4" : "+v"(val) : "s"(lo_), "s"(hi_), "n"(2 * (j)), "n"(2 * (j) + 1)); } while (0)
    if (cnt == need) {
        const unsigned thr = p1 + 4u;
#pragma unroll
        for (int j = 0; j < NJ; ++j) SEL_PUT(j, __ballot(sl[j] < thr));
    } else {
        int base = 0;
#pragma unroll
        for (int j = 0; j < NJ; ++j) {
            const unsigned sj = sl[j];
            SEL_PUT(j, __ballot(sj < p1));
            const bool is = sj == p1; const unsigned long long m = __ballot(is);
            if (m != 0ull) {
                if (is) { const int pos = base + (int)__builtin_amdgcn_mbcnt_hi((unsigned)(m >> 32), __builtin_amdgcn_mbcnt_lo((unsigned)m, 0u));
                    int key = 64 * j + lane; asm volatile("" : "+v"(key));
                    u32x2 e; e.x = (unsigned)(2047 - key); e.y = sortable(row[key]);
                    *(LAS u32x2*)(hb + pos * 8) = e; }
                base += __popcll(m);
            }
        }
        asm volatile("" ::: "memory");
        u32x2 me = (u32x2){0u, 0u};
        if (lane < cnt) me = *(const LAS u32x2*)(hb + lane * 8);
        const unsigned long long cme = ((unsigned long long)me.y << 32) | me.x;
        int rank = 0;
        for (int k = 0; k < cnt; ++k) {
            const unsigned long long ck = ((unsigned long long)(unsigned)__builtin_amdgcn_readlane((int)me.y, k) << 32) | (unsigned)__builtin_amdgcn_readlane((int)me.x, k);
            rank += (ck > cme) ? 1 : 0;
        }
        *(LAS unsigned*)(hb + 1024 + lane * 4) = val;
        asm volatile("" ::: "memory");
        if (lane < cnt && rank < need) { const unsigned key = 2047u - me.x;
            __hip_atomic_fetch_or((LAS unsigned*)(hb + 1024 + (key >> 5) * 4), 1u << (key & 31u), __ATOMIC_RELAXED, __HIP_MEMORY_SCOPE_WAVEFRONT); }
        asm volatile("" ::: "memory");
        val = *(const LAS unsigned*)(hb + 1024 + lane * 4);
    }
#undef SEL_PUT
    return val;
}
struct IdxQ { bf16x8 qf[8][2]; float wh[8]; };
__device__ __forceinline__ void idx_load_q(IdxQ& Q, const Params& P, int b, int qb16, int lane) {
    const bf16_t* IQ = (const bf16_t*)(P.ws + WS_IQ); const float* IW = (const float*)(P.ws + WS_IW);
    const int fr = lane & 15, fq = lane >> 4; const size_t tokq = (size_t)b * SEQ + 16 * qb16 + fr;
#pragma unroll
    for (int h = 0; h < 8; ++h)
#pragma unroll
        for (int ks = 0; ks < 2; ++ks) Q.qf[h][ks] = *(const bf16x8*)(IQ + tokq * 512 + h * 64 + ks * 32 + fq * 8);
    const f32x4 w0 = *(const f32x4*)(IW + tokq * 8), w1 = *(const f32x4*)(IW + tokq * 8 + 4);
#pragma unroll
    for (int e = 0; e < 4; ++e) { Q.wh[e] = w0[e]; Q.wh[4 + e] = w1[e]; }
}
__device__ __forceinline__ void idx_q_finish(IdxQ& Q) {
#pragma unroll
    for (int h = 0; h < 8; ++h) { asm volatile("" : "+v"(Q.qf[h][0]), "+v"(Q.qf[h][1])); asm volatile("" : "+v"(Q.wh[h])); }
}
struct IdxK { bf16x8 ka[4], kb[4]; };
__device__ __forceinline__ void idx_load_k0(IdxK& K, const Params& P, int b, int qb16, int lane, int wave) {
    const bf16_t* IK = (const bf16_t*)(P.ws + WS_IK);
    const int nt = qb16 + 1, fr = lane & 15, fq = lane >> 4; const int nmy = (nt - wave + 7) >> 3;
    const bf16_t* kbase = IK + ((size_t)b * SEQ + wave * 16 + fr) * 64 + fq * 8;
#pragma unroll
    for (int s4 = 0; s4 < 4; ++s4) if (s4 < nmy) { const bf16_t* p_ = kbase + (size_t)s4 * (128 * 64); K.ka[s4] = *(const bf16x8*)p_; K.kb[s4] = *(const bf16x8*)(p_ + 32); }
}
__device__ __forceinline__ void idx_scores(const IdxQ& Q, IdxK& K, const Params& P, int b, int qb16, LAS unsigned char* lds, int lane, int wave) {
    const bf16_t* IK = (const bf16_t*)(P.ws + WS_IK);
    LAS float* sc = (LAS float*)lds;
    const int nt = qb16 + 1, fr = lane & 15, fq = lane >> 4;
    const int nmy = (nt - wave + 7) >> 3;
    const bf16_t* kbase = IK + ((size_t)b * SEQ + wave * 16 + fr) * 64 + fq * 8;
    float tmx = -__builtin_inff(), tnm = -__builtin_inff();
    for (int i0 = 0; i0 < nmy; i0 += 4) {
#pragma unroll
        for (int s4 = 0; s4 < 4; ++s4) {
            const int i = i0 + s4;
            if (i < nmy) {
                const bf16x8 ka = K.ka[s4], kb = K.kb[s4];
                f32x4 s = (f32x4){0.f, 0.f, 0.f, 0.f};
                f32x4 a[8];
#pragma unroll
                for (int h = 0; h < 8; ++h) {
                    a[h] = (f32x4){0.f, 0.f, 0.f, 0.f};
                    a[h] = __builtin_amdgcn_mfma_f32_16x16x32_bf16(ka, Q.qf[h][0], a[h], 0, 0, 0);
                    a[h] = __builtin_amdgcn_mfma_f32_16x16x32_bf16(kb, Q.qf[h][1], a[h], 0, 0, 0);
                }
                if (i + 4 < nmy) { const bf16_t* p_ = kbase + (size_t)(i + 4) * (128 * 64); K.ka[s4] = *(const bf16x8*)p_; K.kb[s4] = *(const bf16x8*)(p_ + 32); }
#pragma unroll
                for (int h = 0; h < 8; ++h)
#pragma unroll
                    for (int e = 0; e < 4; ++e) { const float ae = a[h][e]; s[e] = __builtin_fmaf(Q.wh[h], __int_as_float(max(__float_as_int(ae), 0)), s[e]); }
                *(LAS f32x4*)(sc + fr * SC_PITCH + (wave + 8 * i) * 16 + fq * 4) = s;
                tmx = fmaxf(fmaxf(tmx, s[0]), fmaxf(s[1], fmaxf(s[2], s[3]))); tnm = fmaxf(fmaxf(tnm, -s[0]), fmaxf(-s[1], fmaxf(-s[2], -s[3])));
            }
        }
    }
    if (nmy > 0) { LAS float* mm = (LAS float*)(lds + SEL_MM) + 2 * fr;
        __hip_atomic_fetch_max(mm, tmx, __ATOMIC_RELAXED, __HIP_MEMORY_SCOPE_WORKGROUP); __hip_atomic_fetch_max(mm + 1, tnm, __ATOMIC_RELAXED, __HIP_MEMORY_SCOPE_WORKGROUP); }
}
template <int NJ>
__device__ __forceinline__ unsigned select_any(const LAS float* row, int qpos, LAS unsigned char* hb, const LAS float* mm, int lane) {
    bool ok; const unsigned v = select_fast<NJ>(row, qpos, hb, mm, lane, ok);
    if (ok) return v;
    return select_row<NJ>(row, qpos, lane);
}
__device__ __forceinline__ unsigned idx_select_one(int qpos, const LAS float* row, LAS unsigned char* hb, const LAS float* mm, int lane) {
    const int jn = (qpos >> 6) + 1;
    if (jn <= 4) return select_row<4>(row, qpos, lane);
    else if (jn <= 8) return select_any<8>(row, qpos, hb, mm, lane);
    else if (jn <= 12) return select_any<12>(row, qpos, hb, mm, lane);
    else if (jn <= 16) return select_any<16>(row, qpos, hb, mm, lane);
    else if (jn <= 20) return select_any<20>(row, qpos, hb, mm, lane);
    else if (jn <= 24) return select_any<24>(row, qpos, hb, mm, lane);
    else if (jn <= 28) return select_any<28>(row, qpos, hb, mm, lane);
    else return select_any<32>(row, qpos, hb, mm, lane);
}
__device__ __forceinline__ void idx_select(const Params& P, int b, int qb16, LAS unsigned char* lds, int lane, int wave, IdxQ& Q, IdxK& K, bool has_next) {
    unsigned* SEL = (unsigned*)(P.ws + WS_SEL); LAS float* sc = (LAS float*)lds; const int q0 = 16 * qb16;
    const int ql0 = 2 * wave, qpos0 = q0 + ql0;
    LAS unsigned char* hb = lds + SEL_HB + wave * SEL_HB_STRIDE;
    const unsigned v0 = idx_select_one(qpos0, sc + ql0 * SC_PITCH, hb, (const LAS float*)(lds + SEL_MM) + 2 * ql0, lane);
    if (has_next) { idx_q_finish(Q);
#pragma unroll
        for (int s4 = 0; s4 < 4; ++s4) asm volatile("" : "+v"(K.ka[s4]), "+v"(K.kb[s4])); }
    SEL[((size_t)b * SEQ + qpos0) * 64 + lane] = v0;
    const unsigned v1 = idx_select_one(qpos0 + 1, sc + (ql0 + 1) * SC_PITCH, hb, (const LAS float*)(lds + SEL_MM) + 2 * ql0 + 2, lane);
    SEL[((size_t)b * SEQ + qpos0 + 1) * 64 + lane] = v1;
}
__device__ __forceinline__ void idx_phase(const Params& P, int vcu, int G, LAS unsigned char* lds, int lane, int wave) {
    const int npair = (BATCH * 64 - vcu + G - 1) / G; const int nunit = 2 * npair;
    if (nunit <= 0) return;
    IdxQ Q; IdxK K;
    { const int pi = vcu; idx_load_q(Q, P, pi >> 6, pi & 63, lane); idx_load_k0(K, P, pi >> 6, pi & 63, lane, wave); idx_q_finish(Q); }
    if (lane < 4) ((LAS float*)(lds + SEL_MM))[4 * wave + lane] = -__builtin_inff();
    __syncthreads();
#pragma unroll 1
    for (int un = 0; un < nunit; ++un) {
        const int pi = vcu + (un >> 1) * G; const int b = pi >> 6, qb = (un & 1) ? 127 - (pi & 63) : (pi & 63);
        idx_scores(Q, K, P, b, qb, lds, lane, wave);
        if (DBL_MASK & 128) { __syncthreads(); idx_load_k0(K, P, b, qb, lane, wave); idx_scores(Q, K, P, b, qb, lds, lane, wave); }
        __syncthreads();
        if (un + 1 < nunit) { const int pn = vcu + ((un + 1) >> 1) * G; const int bn = pn >> 6, qn = ((un + 1) & 1) ? 127 - (pn & 63) : (pn & 63);
            idx_load_q(Q, P, bn, qn, lane); idx_load_k0(K, P, bn, qn, lane, wave); }
        idx_select(P, b, qb, lds, lane, wave, Q, K, un + 1 < nunit);
        if (DBL_MASK & 256) idx_select(P, b, qb, lds, lane, wave, Q, K, false);
        asm volatile("" ::: "memory");
        if (lane < 4) ((LAS float*)(lds + SEL_MM))[4 * wave + lane] = -__builtin_inff();
        __syncthreads();
    }
}

constexpr int ASLOT = 32768, AV_OFF = 16384;
__device__ __forceinline__ int crow(int r, int hi) { return (r & 3) + 8 * (r >> 2) + 4 * hi; }
__device__ __forceinline__ s16x4 vtr(const LAS unsigned char* p) { typedef short v4i16_t __attribute__((ext_vector_type(4))); return __builtin_bit_cast(s16x4, __builtin_amdgcn_ds_read_tr16_b64_v4i16((LAS v4i16_t*)p)); }
struct AttnNext { const bf16_t* Kg; const bf16_t* Vg; const bf16_t* Qg; bool has; };

__device__ __forceinline__ void glds16(const void* gsrc, unsigned lds_dst) { unsigned keep;
    asm volatile("s_mov_b32 %0, m0\n\ts_mov_b32 m0, %2\n\ts_nop 0\n\tglobal_load_lds_dwordx4 %1, off\n\ts_mov_b32 m0, %0" : "=&s"(keep) : "v"(gsrc), "s"(lds_dst) : "memory"); }
#define LDSADDR(p) ((unsigned)__builtin_amdgcn_readfirstlane((int)(unsigned)(size_t)(p)))
template <int KD>
__device__ __forceinline__ void attn_dma(const bf16_t* Kg, const bf16_t* Vg, int t, LAS unsigned char* slot, int wid, int lane) {
    if (KD == 128) {
#pragma unroll
        for (int i = 0; i < 2; ++i) { const int P = wid + 8 * i, row = 4 * P + (lane >> 4), c = (lane & 15) ^ (row & 15);
            glds16(Kg + (size_t)(64 * t + row) * 512 + c * 8, LDSADDR(slot + P * 1024)); }
    } else {
        const int P = wid, row = 8 * P + (lane >> 3), c = (lane & 7) ^ ((row >> 1) & 7);
        glds16(Kg + (size_t)(64 * t + row) * 512 + c * 8, LDSADDR(slot + P * 1024));
    }
#pragma unroll
    for (int i = 0; i < 2; ++i) { const int P = wid + 8 * i, row = 4 * P + (lane >> 4), pc = lane & 15, c = (((pc >> 2) ^ (row & 3)) << 2) | (pc & 3);
        glds16(Vg + (size_t)(64 * t + row) * 512 + c * 8, LDSADDR(slot + ((KD == 128) ? 16384 : 8192) + P * 1024)); }
}

template <int KD, bool TM>
__device__ __forceinline__ void attn_pass(f32x16 (&o)[4], float& lsum, bf16x8 (&qf)[KD / 16], const bf16_t* Kg, const bf16_t* Vg, const unsigned* SELq  ,
                                          int q0, int wid, int lane, LAS unsigned char* lds, int (&ring)[3], const AttnNext& nx) {
    constexpr int NKS = KD / 16, KROW = KD * 2, NDMA = (KD == 128) ? 4 : 3;
    const int r32 = lane & 31, hi = lane >> 5;
#pragma unroll
    for (int d = 0; d < 4; ++d)
#pragma unroll
        for (int r = 0; r < 16; ++r) o[d][r] = 0.f;
    constexpr bool NEGM = !TM;
    float mrun = NEGM ? 0.f : -1e30f, l = 0.f;
    f32x16 negm;
#pragma unroll
    for (int r = 0; r < 16; ++r) negm[r] = 0.f;
    const int NT = (q0 + 256) / 64, tlast = q0 / 64 + (wid >> 1);
    const int kswz = (KD == 128) ? (r32 & 15) : ((r32 >> 1) & 7);
    const int kbase = r32 * KROW + ((hi ^ kswz) << 4);
    const int vq = (lane & 15) >> 2;
    const int vbase = (4 * hi + vq) * 256 + (vq << 6) + 32 * ((lane >> 4) & 1) + 8 * (lane & 3);
    u32x2 selw_next = (u32x2){0u, 0u};
    if (TM) selw_next = *(const u32x2*)(SELq);
    for (int t = 0; t < NT; ++t) {
        LAS unsigned char* cur = lds + ring[0]; LAS unsigned char* dst = lds + ring[2];
        const u32x2 selw = selw_next;
        const bool act = t <= tlast;
        f32x16 p[2];
        if (act) {
            const LAS unsigned char* kb = cur;
#pragma unroll
            for (int u = 0; u < 2; ++u) {
                bf16x8 kf[NKS];
#pragma unroll
                for (int ks = 0; ks < NKS; ++ks) kf[ks] = *(const LAS bf16x8*)(kb + u * 32 * KROW + (kbase ^ (ks << 5)));
                if (NEGM) p[u] = negm;
                else {
#pragma unroll
                    for (int r = 0; r < 16; ++r) p[u][r] = 0.f;
                }
#pragma unroll
                for (int ks = 0; ks < NKS; ++ks) p[u] = __builtin_amdgcn_mfma_f32_32x32x16_bf16(kf[ks], qf[ks], p[u], 0, 0, 0);
            }
            if (TM) {
#pragma unroll
                for (int u = 0; u < 2; ++u) { const unsigned w = selw[u] >> (4 * hi);
#pragma unroll
                    for (int r = 0; r < 16; ++r) { const unsigned m = (unsigned)__builtin_amdgcn_sbfe((int)w, (r & 3) + 8 * (r >> 2), 1);
                        const float x = p[u][r]; const unsigned xb = __float_as_uint(x); p[u][r] = __uint_as_float((m & xb) | (~m & 0xff800000u)); } }
            } else if (t == tlast) {
                const int qrel = 32 * (wid & 1) + r32;
#pragma unroll
                for (int u = 0; u < 2; ++u)
#pragma unroll
                    for (int r = 0; r < 16; ++r) { if (32 * u + crow(r, hi) > qrel) p[u][r] = -INFINITY; }
            }
        }
        bool issued = true;
        if (TM && t + 1 < NT) selw_next = *(const u32x2*)(SELq + 2 * (t + 1));
        if (t + 2 < NT) attn_dma<KD>(Kg, Vg, t + 2, dst, wid, lane);
        else if (nx.has) attn_dma<KD>(nx.Kg, nx.Vg, t + 2 - NT, dst, wid, lane);
        else issued = false;
        if (act) {
            const LAS unsigned char* vb = cur + ((KD == 128) ? 16384 : 8192);
            float rm;
            { float a = fmaxf(fmaxf(p[0][0], p[0][1]), p[1][0]), b = fmaxf(fmaxf(p[0][2], p[0][3]), p[1][1]); a = fmaxf(fmaxf(a, p[1][2]), p[1][3]);
#pragma unroll
              for (int r = 4; r < 16; r += 4) { a = fmaxf(fmaxf(a, p[0][r]), p[0][r + 1]); b = fmaxf(fmaxf(b, p[0][r + 2]), p[0][r + 3]); a = fmaxf(fmaxf(a, p[1][r]), p[1][r + 1]); b = fmaxf(fmaxf(b, p[1][r + 2]), p[1][r + 3]); }
              rm = fmaxf(a, b); }
            rm = fmaxf(rm, __shfl_xor(rm, 32));
            if (NEGM) {
                if (t == 0 || __any(rm > 8.0f)) {
                    const float dl = (t == 0) ? rm : fmaxf(rm, 0.f), alpha = (t == 0) ? 1.f : __builtin_amdgcn_exp2f(-dl); mrun += dl; l *= alpha;
#pragma unroll
                    for (int u = 0; u < 2; ++u)
#pragma unroll
                        for (int r = 0; r < 16; ++r) p[u][r] -= dl;
#pragma unroll
                    for (int d = 0; d < 4; ++d)
#pragma unroll
                        for (int r = 0; r < 16; ++r) o[d][r] *= alpha;
#pragma unroll
                    for (int r = 0; r < 16; ++r) negm[r] = -mrun;
                }
            } else if (__any(rm > mrun + 8.0f)) {
                const float mn = fmaxf(mrun, rm), alpha = __builtin_amdgcn_exp2f(mrun - mn); mrun = mn; l *= alpha;
#pragma unroll
                for (int d = 0; d < 4; ++d)
#pragma unroll
                    for (int r = 0; r < 16; ++r) o[d][r] *= alpha;
            }
            float ps = 0.f;
#pragma unroll
            for (int u = 0; u < 2; ++u)
#pragma unroll
                for (int r = 0; r < 16; ++r) { p[u][r] = __builtin_amdgcn_exp2f(NEGM ? p[u][r] : p[u][r] - mrun); ps += p[u][r]; }
            l += ps;
#pragma unroll
            for (int u = 0; u < 2; ++u)
#pragma unroll
                for (int s = 0; s < 2; ++s) {
                    u32x4 pw; pw.x = pk2(p[u][8 * s], p[u][8 * s + 1]); pw.y = pk2(p[u][8 * s + 2], p[u][8 * s + 3]); pw.z = pk2(p[u][8 * s + 4], p[u][8 * s + 5]); pw.w = pk2(p[u][8 * s + 6], p[u][8 * s + 7]);
                    const bf16x8 pf = __builtin_bit_cast(bf16x8, pw);
                    const LAS unsigned char* vp = vb + (32 * u + 16 * s) * 256;
                    s16x4 lo[4], hh[4];
#pragma unroll
                    for (int d = 0; d < 4; ++d) { lo[d] = vtr(vp + (vbase ^ (d << 6))); hh[d] = vtr(vp + (vbase ^ (d << 6)) + 8 * 256); }
#pragma unroll
                    for (int d = 0; d < 4; ++d) {
                        const bf16x8 vf = (bf16x8){lo[d][0], lo[d][1], lo[d][2], lo[d][3], hh[d][0], hh[d][1], hh[d][2], hh[d][3]};
                        o[d] = __builtin_amdgcn_mfma_f32_32x32x16_bf16(vf, pf, o[d], 0, 0, 0);
                    }
                }
        }
        if (issued) asm volatile("s_waitcnt vmcnt(%0) lgkmcnt(0)" :: "n"(NDMA) : "memory");
        else asm volatile("s_waitcnt vmcnt(0) lgkmcnt(0)" ::: "memory");
        __builtin_amdgcn_s_barrier();
        asm volatile("" ::: "memory");
        { const int r0 = ring[0]; ring[0] = ring[1]; ring[1] = ring[2]; ring[2] = r0; }
    }
    if (nx.has) {
#pragma unroll
        for (int ks = 0; ks < NKS; ++ks) qf[ks] = *(const bf16x8*)(nx.Qg + (size_t)r32 * 1024 + 16 * ks + 8 * hi);
    }
    lsum = l + __shfl_xor(l, 32);
}
template <int NKS>
__device__ __forceinline__ void attn_load_q(bf16x8 (&qf)[NKS], const bf16_t* Qg, int lane) {
#pragma unroll
    for (int ks = 0; ks < NKS; ++ks) qf[ks] = *(const bf16x8*)(Qg + (size_t)(lane & 31) * 1024 + 16 * ks + 8 * (lane >> 5));
}

__device__ __forceinline__ void attn_store_rows(const f32x16 (&o)[4], float rowscale, LAS unsigned char* stg, const bf16_t* gate0  ,
                                                bf16_t* out0  , const float* sw, int lane) {
    const int r32 = lane & 31, hi = lane >> 5;
    const unsigned gl = (unsigned)((lane >> 3) * 512 + 8 * (lane & 7)) * 2u, ol = (unsigned)((lane >> 3) * 1024 + 8 * (lane & 7)) * 2u;
    const int wl = r32 * 128 + 8 * hi, rl = (lane >> 3) * 128;
#pragma unroll
    for (int hf = 0; hf < 2; ++hf) {
        u32x4 gv[4];
#pragma unroll
        for (int i = 0; i < 4; ++i) gv[i] = *(const u32x4*)((const unsigned char*)gate0 + (i * 8 * 512 + 64 * hf) * 2 + gl);
#pragma unroll
        for (int dd = 0; dd < 2; ++dd)
#pragma unroll
            for (int g = 0; g < 4; ++g) { const int d = 2 * hf + dd; u32x2 w; w.x = pk2(o[d][4 * g] * rowscale, o[d][4 * g + 1] * rowscale); w.y = pk2(o[d][4 * g + 2] * rowscale, o[d][4 * g + 3] * rowscale);
                *(LAS u32x2*)(stg + wl + (((dd * 4 + g) ^ (r32 & 7)) << 4)) = w; }
        asm volatile("s_waitcnt lgkmcnt(0)" ::: "memory");
        f32x4 w0 = (f32x4){1.f, 1.f, 1.f, 1.f}, w1 = w0;
        if (sw) { w0 = *(const f32x4*)(sw + 64 * hf + 8 * (lane & 7)); w1 = *(const f32x4*)(sw + 64 * hf + 8 * (lane & 7) + 4); }
#pragma unroll
        for (int i = 0; i < 4; ++i) { const int rsw = ((lane >> 3) & 7);
            const u32x4 v = *(const LAS u32x4*)(stg + i * 1024 + rl + (((lane & 7) ^ rsw) << 4));
            const u32x4 g4 = gv[i]; u32x4 r;
            r.x = pk2(bflo(v.x) * w0[0] * bflo(g4.x), bfhi(v.x) * w0[1] * bfhi(g4.x)); r.y = pk2(bflo(v.y) * w0[2] * bflo(g4.y), bfhi(v.y) * w0[3] * bfhi(g4.y));
            r.z = pk2(bflo(v.z) * w1[0] * bflo(g4.z), bfhi(v.z) * w1[1] * bfhi(g4.z)); r.w = pk2(bflo(v.w) * w1[2] * bflo(g4.w), bfhi(v.w) * w1[3] * bfhi(g4.w));
            *(u32x4*)((unsigned char*)out0 + (i * 8 * 1024 + 64 * hf) * 2 + ol) = r; }
        asm volatile("s_waitcnt lgkmcnt(0)" ::: "memory");
    }
}

struct AttnUnit { int b, h, qblk; };
__device__ __forceinline__ AttnUnit attn_unit_of(int vcu, int G, int un) { const int pi = vcu + (un >> 1) * G; AttnUnit u; u.b = pi >> 4; u.h = (pi >> 2) & 3; u.qblk = (un & 1) ? (pi & 3) : 7 - (pi & 3); return u; }
__device__ __forceinline__ void diff_phase(const Params& P, int layer, int vcu, int G, LAS unsigned char* lds, int lane, int wid, bool dummy) {
    bf16_t* QMIX = (bf16_t*)(P.ws + WS_QMIX); const bf16_t* DK = (const bf16_t*)(P.ws + WS_DK); const bf16_t* DV = (const bf16_t*)(P.ws + WS_DV); const bf16_t* DG = (const bf16_t*)(P.ws + WS_DG);
    const float* lamp = (const float*)(P.ws + WS_TAB + TB_LAM);
    const int nunit = 2 * ((BATCH * 16 - vcu + G - 1) / G);
    if (nunit <= 0) return;
    const int r32 = lane & 31, hi = lane >> 5;
    int ring[3] = {0, 24576, 49152}; bf16x8 qf[4];
    { const AttnUnit u0 = attn_unit_of(vcu, G, 0); const size_t tok0 = (size_t)u0.b * SEQ + 256 * u0.qblk + 32 * wid;
      attn_dma<64>(DK + (size_t)u0.b * SEQ * 512 + u0.h * 128, DV + (size_t)u0.b * SEQ * 512 + u0.h * 128, 0, lds + ring[0], wid, lane);
      attn_dma<64>(DK + (size_t)u0.b * SEQ * 512 + u0.h * 128, DV + (size_t)u0.b * SEQ * 512 + u0.h * 128, 1, lds + ring[1], wid, lane);
      attn_load_q<4>(qf, QMIX + tok0 * 1024 + u0.h * 128, lane);
      asm volatile("s_waitcnt vmcnt(0)" ::: "memory"); __builtin_amdgcn_s_barrier(); asm volatile("" ::: "memory"); }
#pragma unroll 1
    for (int un = 0; un < nunit; ++un) {
        const AttnUnit u = attn_unit_of(vcu, G, un);
        const int q0 = 256 * u.qblk; const size_t tok0 = (size_t)u.b * SEQ + q0 + 32 * wid;
        const bf16_t* Kg = DK + (size_t)u.b * SEQ * 512 + u.h * 128; const bf16_t* Vg = DV + (size_t)u.b * SEQ * 512 + u.h * 128;
        float l1;
        LAS unsigned* park = (LAS unsigned*)(lds + 77824 + wid * 8192) + lane;
        f32x16 o1[4];
        { float l0; AttnNext nx{Kg + 64, Vg, QMIX + tok0 * 1024 + u.h * 128 + 64, true};
          attn_pass<64, false>(o1, l0, qf, Kg, Vg, nullptr, q0, wid, lane, lds, ring, nx);
          const float il = 1.f / l0;
#pragma unroll
          for (int d = 0; d < 4; ++d)
#pragma unroll
              for (int i = 0; i < 8; ++i) park[(d * 8 + i) * 64] = pk2(o1[d][2 * i] * il, o1[d][2 * i + 1] * il); }
        { AttnNext nx{nullptr, nullptr, nullptr, false};
          if (un + 1 < nunit) { const AttnUnit v = attn_unit_of(vcu, G, un + 1); nx.Kg = DK + (size_t)v.b * SEQ * 512 + v.h * 128; nx.Vg = DV + (size_t)v.b * SEQ * 512 + v.h * 128;
              nx.Qg = QMIX + ((size_t)v.b * SEQ + 256 * v.qblk + 32 * wid) * 1024 + v.h * 128; nx.has = true; }
          attn_pass<64, false>(o1, l1, qf, Kg + 64, Vg, nullptr, q0, wid, lane, lds, ring, nx); }
        const float lam = lamp[2 * layer], li = lamp[2 * layer + 1];
        { const float f = lam / l1; float ss = 0.f;
#pragma unroll
          for (int d = 0; d < 4; ++d)
#pragma unroll
              for (int i = 0; i < 8; ++i) { const unsigned pw_ = park[(d * 8 + i) * 64]; o1[d][2 * i] = bflo(pw_) - f * o1[d][2 * i]; o1[d][2 * i + 1] = bfhi(pw_) - f * o1[d][2 * i + 1]; ss += o1[d][2 * i] * o1[d][2 * i] + o1[d][2 * i + 1] * o1[d][2 * i + 1]; }
          ss += __shfl_xor(ss, 32);
          const float rs = rsqrtf(ss * (1.f / 128.f) + 1e-5f) * (1.f - li);
          attn_store_rows(o1, rs, lds + 77824 + wid * 8192, DG + tok0 * 512 + u.h * 128, (bf16_t*)(P.ws + (dummy ? WS_DUMMY : WS_QMIX)) + tok0 * 1024 + u.h * 128, P.subln_w + layer * 128, lane); }
    }
}

__device__ __forceinline__ void dsa_phase(const Params& P, int vcu, int G, LAS unsigned char* lds, int lane, int wid, bool dummy) {
    bf16_t* QMIX = (bf16_t*)(P.ws + WS_QMIX); const bf16_t* SK = (const bf16_t*)(P.ws + WS_SK); const bf16_t* SV = (const bf16_t*)(P.ws + WS_SV); const bf16_t* SG = (const bf16_t*)(P.ws + WS_SG);
    const unsigned* SEL = (const unsigned*)(P.ws + WS_SEL);
    const int nunit = 2 * ((BATCH * 16 - vcu + G - 1) / G);
    if (nunit <= 0) return;
    const int r32 = lane & 31, hi = lane >> 5;
    int ring[3] = {0, 32768, 65536}; bf16x8 qf[8];
    { const AttnUnit u0 = attn_unit_of(vcu, G, 0); const size_t tok0 = (size_t)u0.b * SEQ + 256 * u0.qblk + 32 * wid;
      attn_dma<128>(SK + (size_t)u0.b * SEQ * 512 + u0.h * 128, SV + (size_t)u0.b * SEQ * 512 + u0.h * 128, 0, lds + ring[0], wid, lane);
      attn_dma<128>(SK + (size_t)u0.b * SEQ * 512 + u0.h * 128, SV + (size_t)u0.b * SEQ * 512 + u0.h * 128, 1, lds + ring[1], wid, lane);
      attn_load_q<8>(qf, QMIX + tok0 * 1024 + 512 + u0.h * 128, lane);
      asm volatile("s_waitcnt vmcnt(0)" ::: "memory"); __builtin_amdgcn_s_barrier(); asm volatile("" ::: "memory"); }
#pragma unroll 1
    for (int un = 0; un < nunit; ++un) {
        const AttnUnit u = attn_unit_of(vcu, G, un);
        const int q0 = 256 * u.qblk; const size_t tok0 = (size_t)u.b * SEQ + q0 + 32 * wid;
        const bf16_t* Kg = SK + (size_t)u.b * SEQ * 512 + u.h * 128; const bf16_t* Vg = SV + (size_t)u.b * SEQ * 512 + u.h * 128;
        AttnNext nx{nullptr, nullptr, nullptr, false};
        if (un + 1 < nunit) { const AttnUnit v = attn_unit_of(vcu, G, un + 1); nx.Kg = SK + (size_t)v.b * SEQ * 512 + v.h * 128; nx.Vg = SV + (size_t)v.b * SEQ * 512 + v.h * 128;
            nx.Qg = QMIX + ((size_t)v.b * SEQ + 256 * v.qblk + 32 * wid) * 1024 + 512 + v.h * 128; nx.has = true; }
        f32x16 o[4]; float l;
        attn_pass<128, true>(o, l, qf, Kg, Vg, SEL + (tok0 + r32) * 64, q0, wid, lane, lds, ring, nx);
        attn_store_rows(o, 1.f / l, lds + 98304 + wid * 4096, SG + tok0 * 512 + u.h * 128, (bf16_t*)(P.ws + (dummy ? WS_DUMMY : WS_QMIX)) + tok0 * 1024 + 512 + u.h * 128, nullptr, lane);
    }
}

#define XB_TMO      128
#define XB_XCNT(j)  (256  + 64 * (j))
#define XB_XSUB(j)  (1280 + 64 * (j))
#define XB_XGEN(j)  (2304 + 64 * (j))
#define XB_TOP      3328
#define XB_TOPGEN   3392
#define XCD_BAR_WORDS 3456
#define XB_SPIN_CAP (1u << 18)
__device__ __forceinline__ unsigned xb_ld(unsigned* p)              { return __hip_atomic_load(p, __ATOMIC_RELAXED, __HIP_MEMORY_SCOPE_AGENT); }
__device__ __forceinline__ unsigned xb_add(unsigned* p, unsigned v) { return __hip_atomic_fetch_add(p, v, __ATOMIC_RELAXED, __HIP_MEMORY_SCOPE_AGENT); }
__device__ __forceinline__ unsigned xb_xcc_id() { return (unsigned)__builtin_amdgcn_s_getreg((3 << 11) | 20) & 0xFu; }
#define XB_SPIN(cond, bar) do { unsigned _sp = 0; while (cond) { __builtin_amdgcn_s_sleep(1); \
    if ((++_sp & 255u) == 0u) { if (xb_ld(&(bar)[XB_TMO])) break; if (_sp > XB_SPIN_CAP) { atomicAdd(&(bar)[XB_TMO], 1u); break; } } } } while (0)
struct XcdBarrier { unsigned* bar; unsigned x; volatile LAS unsigned* st; };
__device__ __forceinline__ XcdBarrier xcd_barrier_post(unsigned* bar, volatile LAS unsigned* st) {
    XcdBarrier b; b.bar = bar; b.x = xb_xcc_id(); b.st = st;
    if (threadIdx.x == 0) (void)xb_add(&bar[XB_XCNT(b.x)], 1u);
    return b;
}
__device__ __forceinline__ void xcd_barrier_complete(unsigned* bar, unsigned x, unsigned& nloc, unsigned& nx) {
    const unsigned G = gridDim.x * gridDim.y * gridDim.z;
    unsigned sum, cnt, mine, sp = 0u;
    for (;;) {
        sum = 0u; cnt = 0u; mine = 0u;
#pragma unroll
        for (unsigned j = 0; j < 16; ++j) { const unsigned c = xb_ld(&bar[XB_XCNT(j)]); sum += c; cnt += (c > 0u) ? 1u : 0u; mine = (j == x) ? c : mine; }
        if (sum == G) break;
        __builtin_amdgcn_s_sleep(1);
        if ((++sp & 255u) == 0u) { if (xb_ld(&bar[XB_TMO])) break; if (sp > XB_SPIN_CAP) { atomicAdd(&bar[XB_TMO], 1u); break; } }
    }
    nloc = mine > 0u ? mine : 1u; nx = cnt > 0u ? cnt : 1u;
}
__device__ __forceinline__ void xcd_barrier(const XcdBarrier& b) {
    asm volatile("s_waitcnt vmcnt(0)" ::: "memory");
    __syncthreads();
    if (threadIdx.x == 0) {
        unsigned* bar = b.bar;
        __builtin_amdgcn_s_waitcnt(0);
        const unsigned bx_ = xb_xcc_id();
        unsigned nloc = b.st[0], nx = b.st[1];
        if (nloc == 0u) { xcd_barrier_complete(bar, bx_, nloc, nx); b.st[0] = nloc; b.st[1] = nx; }
        const unsigned old = xb_add(&bar[XB_XSUB(bx_)], 1u);
        const unsigned gen = old / nloc;
        if (old + 1u == (gen + 1u) * nloc) {
            __builtin_amdgcn_fence(__ATOMIC_RELEASE, "agent");
            asm volatile("s_waitcnt vmcnt(0)" ::: "memory");
            const unsigned og = xb_add(&bar[XB_TOP], 1u);
            const unsigned tg = og / nx;
            if (og + 1u == (tg + 1u) * nx) xb_add(&bar[XB_TOPGEN], 1u);
            else XB_SPIN(xb_ld(&bar[XB_TOPGEN]) == tg, bar);
            __builtin_amdgcn_fence(__ATOMIC_ACQUIRE, "agent");
            xb_add(&bar[XB_XGEN(bx_)], 1u);
            asm volatile("s_waitcnt vmcnt(0)" ::: "memory");
        } else {
            XB_SPIN(xb_ld(&bar[XB_XGEN(bx_)]) == gen, bar);
            __builtin_amdgcn_fence(__ATOMIC_ACQUIRE, "agent");
            asm volatile("s_waitcnt vmcnt(0)" ::: "memory");
        }
    }
    __syncthreads();
}

__global__ void __launch_bounds__(512, 2) hybrid_fwd(Params P) {
    extern __shared__ __attribute__((aligned(16))) unsigned char lds_raw[];
    LAS unsigned char* lds = (LAS unsigned char*)lds_raw;
    volatile LAS unsigned* bst = (volatile LAS unsigned*)(lds + LDS_BYTES - 64);
    if (threadIdx.x < 16) bst[threadIdx.x] = 0u;
    __syncthreads();
    const XcdBarrier gbar = xcd_barrier_post((unsigned*)(P.ws + WS_CTL) + 4096, bst);
#define GRID_SYNC() xcd_barrier(gbar)
    int tid = threadIdx.x, lane = tid & 63; const int wave = __builtin_amdgcn_readfirstlane(tid >> 6);
#define FRESH_TID() do { tid = threadIdx.x; asm volatile("" : "+v"(tid)); lane = tid & 63; } while (0)
    const int G = gridDim.x; const int bx = blockIdx.x; const int vcu = (G % 8 == 0) ? (bx % 8) * (G / 8) + bx / 8 : bx;

    if (PH_MASK & 1) prep_phase(P, lds, tid, lane, wave);
    GRID_SYNC();
    for (int layer = 0; layer < DEPTH; ++layer) {
        FRESH_TID();
        FRESH_TID();
        if (PH_MASK & 4) {
            pg8::Gemm g{(const bf16_t*)(P.ws + WS_XB), (const bf16_t*)(P.ws + WS_WIN) + (size_t)layer * NPAD * DM, MTOK, NPAD, DM};
            pg8::StaticOrder S; S.init(MTOK, NPAD, G, bx);
            EpiInProj E{P.ws, P.iknw + layer * 64, P.iknb + layer * 64};
            pg8::gemm_phase<EpiInProj, pg8::StaticOrder, true, true>(lds, g, S, E, tid);
            if (layer == 0) {
                const int nfull = (MTOK / 256) * (NPAD / 256) - 9 * G;
                if (bx >= nfull && nfull >= 0 && nfull < G) convert_weights(P, (LAS float*)(lds + wave * 16384), 1, DEPTH, (bx - nfull) * 8 + wave, (G - nfull) * 8, lane);
                else if (nfull < 0 || nfull >= G) convert_weights(P, (LAS float*)(lds + wave * 16384), 1, DEPTH, bx * 8 + wave, G * 8, lane);
            }
            if (DBL_MASK & 4) { __syncthreads(); pg8::gemm_phase<EpiInProj, pg8::StaticOrder, true, true>(lds, g, S, E, tid); }
        }
        GRID_SYNC();
        {
            FRESH_TID();
            for (int rep = 0; rep < ((DBL_MASK & 8) ? 2 : 1); ++rep)
            if (PH_MASK & 8) idx_phase(P, vcu, G, lds, lane, wave);
            FRESH_TID();
            for (int rep = (DBL_MASK & 16) ? 0 : 1; rep < 2; ++rep)
            if (PH_MASK & 16) { if (wave >= 4) __builtin_amdgcn_s_setprio(1); diff_phase(P, layer, vcu, G, lds, lane, wave, rep == 0); if (wave >= 4) __builtin_amdgcn_s_setprio(0); }
        }
        GRID_SYNC();
        {
            FRESH_TID();
            for (int rep = (DBL_MASK & 32) ? 0 : 1; rep < 2; ++rep)
            if (PH_MASK & 32) { if (wave >= 4) __builtin_amdgcn_s_setprio(1); dsa_phase(P, vcu, G, lds, lane, wave, rep == 0); if (wave >= 4) __builtin_amdgcn_s_setprio(0); }
        }
        GRID_SYNC();
        FRESH_TID();
        if (PH_MASK & 64) {
            pg8::Gemm g{(const bf16_t*)(P.ws + WS_QMIX), (const bf16_t*)(P.ws + WS_WOUT) + (size_t)layer * DM * DM, MTOK, DM, DM};
            pg8::StaticOrder S; S.init(MTOK, DM, G, bx);
            EpiOutNorm E{P.ws, P.post_w + layer * DM, P.out, layer, layer == DEPTH - 1};
            pg8::gemm_phase<EpiOutNorm, pg8::StaticOrder, true, true>(lds, g, S, E, tid);
        }
        if (layer + 1 < DEPTH) GRID_SYNC();
    }
}

extern "C" void kernel_launch(void* const* d_in, const int* in_sizes, int n_in, void* d_out, int out_size, void* d_ws, size_t ws_size, hipStream_t stream) {
    static int grid_blocks = 0;
    if (grid_blocks == 0) {
        if (n_in != 13 || in_sizes[0] != MTOK * DM || out_size != MTOK * DM || ws_size < WS_END) {
            fprintf(stderr, "kernel_launch: unexpected shapes (n_in %d, in0 %d, out %d, ws %zu); nothing launched\n", n_in, n_in > 0 ? in_sizes[0] : -1, out_size, ws_size); grid_blocks = -1; return; }
        int dev = 0, cus = 0, per_cu = 0;
        hipGetDevice(&dev); hipDeviceGetAttribute(&cus, hipDeviceAttributeMultiprocessorCount, dev);
        hipFuncSetAttribute((const void*)hybrid_fwd, hipFuncAttributeMaxDynamicSharedMemorySize, LDS_BYTES);
        hipOccupancyMaxActiveBlocksPerMultiprocessor(&per_cu, (const void*)hybrid_fwd, 512, LDS_BYTES);
        if (per_cu < 1) { fprintf(stderr, "kernel_launch: occupancy query says %d blocks per CU\n", per_cu); per_cu = 1; }
        grid_blocks = cus;
        (void)hipGetLastError();
    }
    if (grid_blocks < 0) return;
    if (hipMemsetAsync((char*)d_ws + WS_CTL, 0, 524288, stream) != hipSuccess) { fprintf(stderr, "kernel_launch: memset failed\n"); return; }
    Params p{};
    p.x = (const float*)d_in[0]; p.positions = (const int*)d_in[1]; p.pre_w = (const float*)d_in[2]; p.post_w = (const float*)d_in[3]; p.w_in = (const float*)d_in[4]; p.w_out = (const float*)d_in[5];
    p.lq1 = (const float*)d_in[6]; p.lk1 = (const float*)d_in[7]; p.lq2 = (const float*)d_in[8]; p.lk2 = (const float*)d_in[9]; p.subln_w = (const float*)d_in[10]; p.iknw = (const float*)d_in[11]; p.iknb = (const float*)d_in[12];
    p.out = (float*)d_out; p.ws = (unsigned char*)d_ws;
    void* args[] = {&p};
    hipError_t e = hipLaunchCooperativeKernel((const void*)hybrid_fwd, dim3(grid_blocks), dim3(512), args, LDS_BYTES, stream);
    if (e != hipSuccess) fprintf(stderr, "cooperative launch failed: %s (grid %d)\n", hipGetErrorString(e), grid_blocks);
}
```
